# Optimizing an MI355X kernel written in HIP

```python
import functools
import jax
import jax.numpy as jnp
from jax import lax
import numpy as np

D_MODEL = 1024
BATCH = 1
SEQ = 16384
DEPTH = 1
DEC_BATCH = 32
DEC_SEQ = 1
PAST_LEN = 16384
PAGE_SIZE = 128

NSA_HEADS = 8
NSA_KV_HEADS = 2
NSA_GROUP = NSA_HEADS // NSA_KV_HEADS
HEAD_DIM = 64
CMP_LEN = 32
CMP_STRIDE = 16
SEL_BLOCK = 64
N_SEL = 16
WINDOW = 512
Q_BLOCK = 128
RET_HEADS = 4
RET_DK = 128
RET_DV = 256
RET_CHUNK = 128
D_FF = 4 * D_MODEL

ROPE_THETA = 10000.0
RMS_EPS = 1e-6
GN_EPS = 1e-5
NEG_INF = -1e30
FORCE_SCORE = 1e4

NSA_Q_W = NSA_HEADS * HEAD_DIM
NSA_KV_W = 2 * NSA_KV_HEADS * HEAD_DIM
RET_QK_W = RET_HEADS * RET_DK
RET_V_W = RET_HEADS * RET_DV
SPLITS = (NSA_Q_W, NSA_KV_W, NSA_KV_W, NSA_KV_W, 3 * NSA_HEADS, RET_QK_W, RET_QK_W, RET_V_W, RET_V_W, D_MODEL, D_MODEL)
IN_WIDTH = sum(SPLITS)

kernel_name = "nsa_retention_hybrid_step"


def _split_points():
    pts, acc = [], 0
    for w in SPLITS[:-1]:
        acc += w
        pts.append(acc)
    return pts


def rms_norm(x, g):
    xf = x.astype(jnp.float32)
    y = xf * lax.rsqrt(jnp.mean(xf * xf, axis=-1, keepdims=True) + RMS_EPS)
    return (y * g.astype(jnp.float32)).astype(x.dtype)


def rope(x, pos):
    d = x.shape[-1]
    inv = ROPE_THETA ** (-jnp.arange(0, d, 2, dtype=jnp.float32) / d)
    ang = pos.astype(jnp.float32)[:, None] * inv[None, :]
    cos = jnp.cos(ang)[None, :, None, :]
    sin = jnp.sin(ang)[None, :, None, :]
    xf = x.astype(jnp.float32)
    x1, x2 = xf[..., : d // 2], xf[..., d // 2:]
    return jnp.concatenate([x1 * cos - x2 * sin, x1 * sin + x2 * cos], axis=-1).astype(x.dtype)


def rope_kv(kv, pos):
    return jnp.stack([rope(kv[:, :, 0], pos), kv[:, :, 1]], axis=2)


def nsa_compress(rows, w_cmp, b_cmp):
    B, L = rows.shape[:2]
    rb = rows.reshape(B, L // CMP_STRIDE, CMP_STRIDE, 2, NSA_KV_HEADS, HEAD_DIM).astype(jnp.float32)
    first = jnp.einsum('bnjchd,chjd->bnchd', rb, w_cmp[:, :, :CMP_STRIDE].astype(jnp.float32))
    second = jnp.einsum('bnjchd,chjd->bnchd', rb, w_cmp[:, :, CMP_STRIDE:].astype(jnp.float32))
    return first[:, :-1] + second[:, 1:] + b_cmp.astype(jnp.float32)


def nsa_core(q, qpos, cmp, kc_end, gather_sel, kwv, kwpos, gates):
    B, Q = q.shape[:2]
    qg = q.astype(jnp.float32).reshape(B, Q, NSA_KV_HEADS, NSA_GROUP, HEAD_DIM) * (HEAD_DIM ** -0.5)
    mc = (kc_end[None, :] <= qpos[:, None])[None, :, None, None, :]
    s_c = jnp.einsum('bqhgd,bnhd->bqhgn', qg, cmp[:, :, 0])
    p_c = jax.nn.softmax(jnp.where(mc, s_c, NEG_INF), axis=-1) * mc
    o_c = jnp.einsum('bqhgn,bnhd->bqhgd', p_c, cmp[:, :, 1])
    nc = cmp.shape[1]
    ns = (nc + 1) * CMP_STRIDE // SEL_BLOCK
    r = SEL_BLOCK // CMP_STRIDE
    imp = jnp.pad(p_c.sum(axis=3), ((0, 0), (0, 0), (0, 0), (1, r * ns - nc)))
    p_slc = imp[..., : r * ns].reshape(B, Q, NSA_KV_HEADS, ns, r).sum(-1) + imp[..., r::r]
    blk = jnp.arange(ns)
    qblk = (qpos // SEL_BLOCK)[:, None]
    valid = blk[None, :] * SEL_BLOCK <= qpos[:, None]
    forced = (blk[None, :] == 0) | (blk[None, :] == qblk) | (blk[None, :] == qblk - 1)
    score = jnp.where(valid[None, :, None, :], p_slc + jnp.where(forced, FORCE_SCORE, 0.0)[None, :, None, :], NEG_INF)
    _, idx = lax.top_k(score, min(N_SEL, ns))
    kk = idx.shape[-1]
    k_sel, v_sel = gather_sel(idx)
    tpos = idx[..., None] * SEL_BLOCK + jnp.arange(SEL_BLOCK)
    ms = (tpos <= qpos[None, :, None, None, None])[:, :, :, None]
    s_s = jnp.einsum('bqhgd,bqhksd->bqhgks', qg, k_sel)
    s_s = jnp.where(ms, s_s, NEG_INF).reshape(B, Q, NSA_KV_HEADS, NSA_GROUP, kk * SEL_BLOCK)
    p_s = jax.nn.softmax(s_s, axis=-1)
    o_s = jnp.einsum('bqhgm,bqhmd->bqhgd', p_s, v_sel.reshape(B, Q, NSA_KV_HEADS, kk * SEL_BLOCK, HEAD_DIM))
    kp = kwpos[None, :]
    mw = ((kp <= qpos[:, None]) & (kp > qpos[:, None] - WINDOW) & (kp >= 0))[None, :, None, None, :]
    s_w = jnp.einsum('bqhgd,bwhd->bqhgw', qg, kwv[:, :, 0])
    p_w = jax.nn.softmax(jnp.where(mw, s_w, NEG_INF), axis=-1)
    o_w = jnp.einsum('bqhgw,bwhd->bqhgd', p_w, kwv[:, :, 1])
    g = gates.reshape(B, Q, NSA_KV_HEADS, NSA_GROUP, 3)
    o = g[..., 0:1] * o_c + g[..., 1:2] * o_s + g[..., 2:3] * o_w
    return o.reshape(B, Q, NSA_Q_W)


def nsa_prompt(q, gates, kv_c, kv_s, kv_w, w_cmp, b_cmp):
    B, T = q.shape[:2]
    cmp = nsa_compress(kv_c, w_cmp, b_cmp)
    kc_end = jnp.arange(cmp.shape[1]) * CMP_STRIDE + (CMP_LEN - 1)
    sel_blocks = kv_s.reshape(B, T // SEL_BLOCK, SEL_BLOCK, 2, NSA_KV_HEADS, HEAD_DIM)
    bi = jnp.arange(B)[:, None, None, None]
    hi = jnp.arange(NSA_KV_HEADS)[None, None, :, None]

    def gather_sel(idx):
        g = sel_blocks[bi, idx, :, :, hi, :]
        return g[..., 0, :], g[..., 1, :]

    kw_pad = jnp.pad(kv_w, ((0, 0), (WINDOW, 0), (0, 0), (0, 0), (0, 0)))

    def block(s0):
        qb = lax.dynamic_slice_in_dim(q, s0, Q_BLOCK, axis=1)
        gb = lax.dynamic_slice_in_dim(gates, s0, Q_BLOCK, axis=1)
        qpos = s0 + jnp.arange(Q_BLOCK)
        kwb = lax.dynamic_slice_in_dim(kw_pad, s0, WINDOW + Q_BLOCK, axis=1)
        kwpos = s0 - WINDOW + jnp.arange(WINDOW + Q_BLOCK)
        return nsa_core(qb, qpos, cmp, kc_end, gather_sel, kwb, kwpos, gb)

    out = lax.map(block, jnp.arange(T // Q_BLOCK) * Q_BLOCK)
    new_win = kv_w[:, T - min(WINDOW, T):]
    return out.swapaxes(0, 1).reshape(B, T, NSA_Q_W), new_win


def nsa_sample(q, gates, kv_c, kv_s, kv_w, cache_cmp, cache_sel, cache_win, page_table, w_cmp, b_cmp):
    B, S = q.shape[:2]
    P = page_table.shape[1] * PAGE_SIZE
    s_pad = -(-S // SEL_BLOCK) * SEL_BLOCK
    pad = ((0, 0), (0, s_pad - S), (0, 0), (0, 0), (0, 0))
    past_c = cache_cmp[page_table].reshape(B, P, 2, NSA_KV_HEADS, HEAD_DIM)
    cmp = nsa_compress(jnp.concatenate([past_c, jnp.pad(kv_c, pad).astype(past_c.dtype)], axis=1), w_cmp, b_cmp)
    kc_end = jnp.arange(cmp.shape[1]) * CMP_STRIDE + (CMP_LEN - 1)
    n_past_blk = P // SEL_BLOCK
    bpp = PAGE_SIZE // SEL_BLOCK
    pool = cache_sel.reshape(cache_sel.shape[0], bpp, SEL_BLOCK, 2, NSA_KV_HEADS, HEAD_DIM)
    new_blocks = jnp.pad(kv_s, pad).astype(cache_sel.dtype).reshape(B, s_pad // SEL_BLOCK, SEL_BLOCK, 2, NSA_KV_HEADS, HEAD_DIM)
    bi = jnp.arange(B)[:, None, None, None]
    hi = jnp.arange(NSA_KV_HEADS)[None, None, :, None]

    def gather_sel(idx):
        jp = jnp.clip(idx, 0, n_past_blk - 1)
        phys = page_table[bi, jp // bpp]
        gp = pool[phys, jp % bpp, :, :, hi, :]
        jn = jnp.clip(idx - n_past_blk, 0, new_blocks.shape[1] - 1)
        gn = new_blocks[bi, jn, :, :, hi, :]
        g = jnp.where((idx < n_past_blk)[..., None, None, None], gp, gn)
        return g[..., 0, :], g[..., 1, :]

    wb = cache_win.shape[1]
    kwv = jnp.concatenate([cache_win, kv_w.astype(cache_win.dtype)], axis=1)
    kwpos = P - wb + jnp.arange(wb + S)
    qpos = P + jnp.arange(S)
    o = nsa_core(q, qpos, cmp, kc_end, gather_sel, kwv, kwpos, gates)
    return o, kwv[:, S:]


def ret_log_decay():
    return jnp.log1p(-jnp.exp2(-5.0 - jnp.arange(RET_HEADS, dtype=jnp.float32)))


def retention_chunk(S, q, k, v):
    lg = ret_log_decay()
    C = q.shape[1]
    i = jnp.arange(C, dtype=jnp.float32)
    diff = i[:, None] - i[None, :]
    D = jnp.where(diff >= 0, jnp.exp(jnp.maximum(diff, 0.0)[None] * lg[:, None, None]), 0.0)
    qf, kf, vf = q.astype(jnp.float32), k.astype(jnp.float32), v.astype(jnp.float32)
    att = jnp.einsum('bihd,bjhd->bhij', qf, kf) * D
    o = jnp.einsum('bhij,bjhe->bihe', att, vf)
    q_dec = jnp.exp((i[:, None] + 1.0) * lg[None, :])
    o = o + jnp.einsum('bihd,bhde->bihe', qf * q_dec[None, :, :, None], S)
    k_dec = jnp.exp((C - 1.0 - i)[:, None] * lg[None, :])
    S_new = jnp.exp(C * lg)[None, :, None, None] * S + jnp.einsum('bjhd,bjhe->bhde', kf * k_dec[None, :, :, None], vf)
    return S_new, o


def retention_prompt(q, k, v):
    B, T = q.shape[:2]
    n = T // RET_CHUNK

    def chunks(a):
        return a.reshape(B, n, RET_CHUNK, a.shape[2], a.shape[3]).swapaxes(0, 1)

    S0 = jnp.zeros((B, RET_HEADS, RET_DK, RET_DV), jnp.float32)

    def step(S, xs):
        return retention_chunk(S, *xs)

    S, o = lax.scan(step, S0, (chunks(q), chunks(k), chunks(v)))
    return o.swapaxes(0, 1).reshape(B, T, RET_HEADS, RET_DV), S


def retention_sample(q, k, v, state):
    S_new, o = retention_chunk(state.astype(jnp.float32), q, k, v)
    return o, S_new


def retention_out(o, gate, gn_w, gn_b):
    B, T = o.shape[:2]
    mu = jnp.mean(o, axis=-1, keepdims=True)
    var = jnp.mean(jnp.square(o - mu), axis=-1, keepdims=True)
    y = ((o - mu) * lax.rsqrt(var + GN_EPS)).reshape(B, T, RET_V_W)
    y = y * gn_w.astype(jnp.float32) + gn_b.astype(jnp.float32)
    return jax.nn.silu(gate.astype(jnp.float32)) * y


def decoder_layer(x, c, pos, nsa_fn, ret_fn, norm_mix, norm_mlp, w_ada, b_ada, w_in,
                  ret_gn_w, ret_gn_b, w_branch_nsa, w_branch_ret, w_out, w_up, w_down):
    B, T, _ = x.shape
    mod = (jax.nn.silu(c) @ w_ada + b_ada)[:, None, :]
    sh_a, sc_a, gt_a, sh_f, sc_f, gt_f = jnp.split(mod, 6, axis=-1)
    h = rms_norm(x, norm_mix) * (1.0 + sc_a) + sh_a
    z = h @ w_in
    q, kv_c, kv_s, kv_w, g_nsa, rq, rk, rv, rg, ga, gb = jnp.split(z, _split_points(), axis=-1)
    q = rope(q.reshape(B, T, NSA_HEADS, HEAD_DIM), pos)
    kv_c = rope_kv(kv_c.reshape(B, T, 2, NSA_KV_HEADS, HEAD_DIM), pos)
    kv_s = rope_kv(kv_s.reshape(B, T, 2, NSA_KV_HEADS, HEAD_DIM), pos)
    kv_w = rope_kv(kv_w.reshape(B, T, 2, NSA_KV_HEADS, HEAD_DIM), pos)
    g_nsa = jax.nn.sigmoid(g_nsa.reshape(B, T, NSA_HEADS, 3).astype(jnp.float32))
    o_nsa, new_win = nsa_fn(q, g_nsa, kv_c, kv_s, kv_w)
    rq = rope(rq.reshape(B, T, RET_HEADS, RET_DK), pos)
    rk = rope(rk.reshape(B, T, RET_HEADS, RET_DK), pos) * (RET_DK ** -0.5)
    rv = rv.reshape(B, T, RET_HEADS, RET_DV)
    o_ret, new_S = ret_fn(rq, rk, rv)
    y_ret = retention_out(o_ret, rg, ret_gn_w, ret_gn_b)
    y_a = o_nsa.astype(x.dtype) @ w_branch_nsa
    y_b = y_ret.astype(x.dtype) @ w_branch_ret
    mixed = (jax.nn.sigmoid(ga) * y_a + jax.nn.sigmoid(gb) * y_b) @ w_out
    x = x + gt_a * mixed
    h = rms_norm(x, norm_mlp) * (1.0 + sc_f) + sh_f
    x = x + gt_f * (jnp.square(jax.nn.relu(h @ w_up)) @ w_down)
    return x, kv_c, kv_s, new_win, new_S


def setup_inputs(seed: int = 0) -> dict:
    key = jax.random.key(seed)
    ks = jax.random.split(key, 24)
    f32 = jnp.float32
    n_pages = PAST_LEN // PAGE_SIZE
    n_used = DEC_BATCH * n_pages
    n_phys = n_used + n_used // 4
    win_buf = min(WINDOW, PAST_LEN)

    def nrm(k, shape, s=1.0):
        return s * jax.random.normal(k, shape, f32)

    page_table = jax.random.permutation(ks[8], n_phys)[:n_used].reshape(DEC_BATCH, n_pages).astype(jnp.int32)
    return {
        'x_prompt': nrm(ks[0], (BATCH, SEQ, D_MODEL)),
        'x_sample': nrm(ks[1], (DEC_BATCH, DEC_SEQ, D_MODEL)),
        'c_prompt': nrm(ks[2], (BATCH, D_MODEL)),
        'c_sample': nrm(ks[3], (DEC_BATCH, D_MODEL)),
        'cache_cmp_kv': nrm(ks[4], (DEPTH, n_phys, PAGE_SIZE, 2, NSA_KV_HEADS, HEAD_DIM)),
        'cache_sel_kv': nrm(ks[5], (DEPTH, n_phys, PAGE_SIZE, 2, NSA_KV_HEADS, HEAD_DIM)),
        'cache_win_kv': nrm(ks[6], (DEPTH, DEC_BATCH, win_buf, 2, NSA_KV_HEADS, HEAD_DIM)),
        'state_ret': nrm(ks[7], (DEPTH, DEC_BATCH, RET_HEADS, RET_DK, RET_DV), 0.1),
        'page_table': page_table,
        'norm_mix': 1.0 + nrm(ks[9], (DEPTH, D_MODEL), 0.02),
        'norm_mlp': 1.0 + nrm(ks[10], (DEPTH, D_MODEL), 0.02),
        'norm_final': 1.0 + nrm(ks[11], (D_MODEL,), 0.02),
        'w_ada': nrm(ks[12], (DEPTH, D_MODEL, 6 * D_MODEL), 0.2 * D_MODEL ** -0.5),
        'b_ada': nrm(ks[13], (DEPTH, 6 * D_MODEL), 0.02),
        'w_in': nrm(ks[14], (DEPTH, D_MODEL, IN_WIDTH), D_MODEL ** -0.5),
        'w_cmp': nrm(ks[15], (DEPTH, 2, NSA_KV_HEADS, CMP_LEN, HEAD_DIM), CMP_LEN ** -0.5),
        'b_cmp': nrm(ks[16], (DEPTH, 2, NSA_KV_HEADS, HEAD_DIM), 0.02),
        'ret_gn_w': 1.0 + nrm(ks[17], (DEPTH, RET_V_W), 0.02),
        'ret_gn_b': nrm(ks[18], (DEPTH, RET_V_W), 0.02),
        'w_branch_nsa': nrm(ks[19], (DEPTH, NSA_Q_W, D_MODEL), NSA_Q_W ** -0.5),
        'w_branch_ret': nrm(ks[20], (DEPTH, RET_V_W, D_MODEL), RET_V_W ** -0.5),
        'w_out': nrm(ks[21], (DEPTH, D_MODEL, D_MODEL), D_MODEL ** -0.5),
        'w_up': nrm(ks[22], (DEPTH, D_MODEL, D_FF), D_MODEL ** -0.5),
        'w_down': nrm(ks[23], (DEPTH, D_FF, D_MODEL), D_FF ** -0.5),
    }


def reference(x_prompt, x_sample, c_prompt, c_sample, cache_cmp_kv, cache_sel_kv, cache_win_kv, state_ret,
              page_table, norm_mix, norm_mlp, norm_final, w_ada, b_ada, w_in, w_cmp, b_cmp, ret_gn_w, ret_gn_b,
              w_branch_nsa, w_branch_ret, w_out, w_up, w_down):
    T = x_prompt.shape[1]
    S = x_sample.shape[1]
    P = page_table.shape[1] * PAGE_SIZE
    pos_p = jnp.arange(T)
    pos_s = P + jnp.arange(S)
    xp, xs = x_prompt, x_sample
    cmp_p, sel_p, win_p, ret_p = [], [], [], []
    cmp_s, sel_s, win_s, ret_s = [], [], [], []
    for l in range(DEPTH):
        lw = (norm_mix[l], norm_mlp[l], w_ada[l], b_ada[l], w_in[l], ret_gn_w[l], ret_gn_b[l],
              w_branch_nsa[l], w_branch_ret[l], w_out[l], w_up[l], w_down[l])
        nsa_p = functools.partial(nsa_prompt, w_cmp=w_cmp[l], b_cmp=b_cmp[l])
        xp, a, b, c, d = decoder_layer(xp, c_prompt, pos_p, nsa_p, retention_prompt, *lw)
        cmp_p.append(a); sel_p.append(b); win_p.append(c); ret_p.append(d)
        nsa_s = functools.partial(nsa_sample, cache_cmp=cache_cmp_kv[l], cache_sel=cache_sel_kv[l],
                                  cache_win=cache_win_kv[l], page_table=page_table, w_cmp=w_cmp[l], b_cmp=b_cmp[l])
        ret_fn = functools.partial(retention_sample, state=state_ret[l])
        xs, a, b, c, d = decoder_layer(xs, c_sample, pos_s, nsa_s, ret_fn, *lw)
        cmp_s.append(a); sel_s.append(b); win_s.append(c); ret_s.append(d)
    y_prompt = rms_norm(xp, norm_final)
    y_sample = rms_norm(xs, norm_final)
    return (y_prompt, y_sample,
            jnp.stack(cmp_p), jnp.stack(sel_p), jnp.stack(win_p), jnp.stack(ret_p),
            jnp.stack(cmp_s), jnp.stack(sel_s), jnp.stack(win_s), jnp.stack(ret_s))
```

```cpp
#include <hip/hip_runtime.h>
#include <cstdio>
#include <cstdint>
namespace pg8 {
#define PG8_LAS __attribute__((address_space(3)))
typedef unsigned short bf16_t;
typedef short bf16x8 __attribute__((ext_vector_type(8)));
typedef float f32x4 __attribute__((ext_vector_type(4)));
typedef unsigned u32x4 __attribute__((ext_vector_type(4)));
constexpr int BM = 256, BK = 64, HALF = 128, HTB = HALF * BK * 2  , STAGE_BYTES = 8 * HTB, NXCD = 8, WGM = 8;

__host__ __device__ __forceinline__ int lds_byte(int r, int c) { const int st = (r >> 4) * 2 + (c >> 5), rr = r & 15, cc = c & 31, ob = rr * 64 + cc * 2; return st * 1024 + (ob ^ (((ob >> 9) & 1) << 5)); }
__host__ __device__ __forceinline__ void stage_rc(int b, int& R, int& C) { const int st = b / 1024, sb = b % 1024, swz = sb ^ (((sb >> 9) & 1) << 5); R = (st >> 1) * 16 + swz / 64; C = (st & 1) * 32 + (swz % 64) / 2; }
__host__ __device__ __forceinline__ int perm32(int rho) { const int n = rho >> 4, i = rho & 15; return 8 * (i >> 2) + 4 * n + (i & 3); }

struct Unit { int pm, pn; };
struct Gemm { const bf16_t* A; const bf16_t* Bt; int M, N, K; };

struct StaticOrder {
    int nM, nN, nwg, G, c;
    __host__ __device__ void init(int M, int N, int G_, int c_) { nM = M / BM; nN = N / BM; nwg = nM * nN; G = G_; c = c_; }
    __host__ __device__ bool next(int i, Unit& u) const {
        const long L = (long)i * G + c; if (L >= nwg) return false;
        int wgid = (int)L; { const int q = nwg / NXCD, r = nwg % NXCD, xcd = wgid % NXCD, off = wgid / NXCD; wgid = (xcd < r ? xcd * (q + 1) : r * (q + 1) + (xcd - r) * q) + off; }
        const int nig = WGM * nN, gid = wgid / nig, fm = gid * WGM, gsz = (nM - fm) < WGM ? (nM - fm) : WGM;
        u.pm = fm + ((wgid % nig) % gsz); u.pn = (wgid % nig) / gsz; return true;
    }
    __device__ __forceinline__ void a_ready(const Unit&) const {}
    __device__ __forceinline__ void done(const Unit&) const {}
};

__device__ __forceinline__ unsigned cvt_pk_bf16(float lo, float hi) { unsigned r; asm volatile("v_cvt_pk_bf16_f32 %0, %1, %2" : "=v"(r) : "v"(lo), "v"(hi)); return r; }
typedef float f32x2 __attribute__((ext_vector_type(2)));
template <class Epi, class Sched, bool ALIGN_EPI = false, bool SP2 = false>
__device__ __forceinline__ void gemm_phase(PG8_LAS unsigned char* lds, const Gemm g, const Sched& S, const Epi& E, const int wid) {
    int lane; asm volatile("v_mbcnt_lo_u32_b32 %0, -1, 0\n\tv_mbcnt_hi_u32_b32 %0, -1, %0" : "=v"(lane));
    const int tid = wid * 64 + lane, wr = wid >> 2, wc = wid & 3, fr = lane & 15, fq = lane >> 4;
    const int K = g.K, nt = K / BK;
    unsigned voffA[2], voffB[2];
#pragma unroll
    for (int i = 0; i < 2; ++i) { int R, C; stage_rc(tid * 16 + i * 8192, R, C); const int Rb = Epi::PERM ? ((R & ~31) + perm32(R & 31)) : R;
        voffA[i] = (unsigned)(R * K + C) * 2u; voffB[i] = (unsigned)(Rb * K + C) * 2u; }
    const size_t kstep = (size_t)(BK * 2);
    const size_t hstep = (size_t)HALF * K * 2;
    const size_t tstep = 2 * hstep;
    const unsigned ldsw = (unsigned)wid * 1024u;
    const int aoff = lds_byte(wr * 64 + fr, fq * 8), boff = lds_byte(wc * 32 + fr, fq * 8);
#define PG8_SA(b, h) (((b) * 2 + (h)) * HTB)
#define PG8_SB(b, h) ((4 + (b) * 2 + (h)) * HTB)
#define PG8_STAGE(bufoff, gbase, voff) do { _Pragma("unroll") for (int _i = 0; _i < 2; ++_i) \
        __builtin_amdgcn_global_load_lds((const unsigned*)((const char*)(gbase) + (voff)[_i]), (PG8_LAS unsigned*)(lds + (bufoff) + ldsw + _i * 8192), 16, 0, 0); } while (0)
#define PG8_LDA(dst, b, h) do { _Pragma("unroll") for (int m = 0; m < 4; ++m) _Pragma("unroll") for (int k = 0; k < 2; ++k) dst[m][k] = *(const PG8_LAS bf16x8*)(lds + PG8_SA(b, h) + aoff + m * 2048 + k * 1024); } while (0)
#define PG8_LDB(dst, b, h) do { _Pragma("unroll") for (int n = 0; n < 2; ++n) _Pragma("unroll") for (int k = 0; k < 2; ++k) dst[n][k] = *(const PG8_LAS bf16x8*)(lds + PG8_SB(b, h) + boff + n * 2048 + k * 1024); } while (0)
#define PG8_MMA(ai, bj, At, Bt) do { __builtin_amdgcn_s_setprio(1); _Pragma("unroll") for (int m = 0; m < 4; ++m) _Pragma("unroll") for (int n = 0; n < 2; ++n) _Pragma("unroll") for (int k = 0; k < 2; ++k) \
        acc[ai][bj][m][n] = __builtin_amdgcn_mfma_f32_16x16x32_bf16(Bt[n][k], At[m][k], acc[ai][bj][m][n], 0, 0, 0); __builtin_amdgcn_s_setprio(0); } while (0)
#define PG8_WAIT_V(n) asm volatile("s_waitcnt vmcnt(" #n ")" ::: "memory")
#define PG8_WAIT_L(n) asm volatile("s_waitcnt lgkmcnt(" #n ")" ::: "memory")
#define PG8_BAR __builtin_amdgcn_s_barrier()
#define PG8_SCHED __builtin_amdgcn_sched_barrier(0)
    Unit cur, nxt; int ui = 0;
    if (!S.next(0, cur)) return;
    f32x4 acc[2][2][4][2];
#pragma unroll
    for (int a = 0; a < 2; ++a)
#pragma unroll
        for (int b = 0; b < 2; ++b)
#pragma unroll
            for (int m = 0; m < 4; ++m)
#pragma unroll
                for (int n = 0; n < 2; ++n) acc[a][b][m][n] = (f32x4){0.f, 0.f, 0.f, 0.f};
    bf16x8 At[4][2], B0[2][2], B1[2][2];
    const char* cA = (const char*)g.A + (size_t)cur.pm * tstep; const char* cB = (const char*)g.Bt + (size_t)cur.pn * tstep;
    S.a_ready(cur);
    if constexpr (SP2) {
        PG8_STAGE(PG8_SB(0, 0), cB, voffB); PG8_STAGE(PG8_SB(0, 1), cB + hstep, voffB); PG8_STAGE(PG8_SA(0, 0), cA, voffA); PG8_STAGE(PG8_SA(0, 1), cA + hstep, voffA);
        if (wr == 1) PG8_BAR;
        PG8_WAIT_V(2); PG8_BAR;
        PG8_STAGE(PG8_SB(1, 0), cB + kstep, voffB); PG8_STAGE(PG8_SA(1, 0), cA + kstep, voffA); PG8_STAGE(PG8_SB(1, 1), cB + hstep + kstep, voffB);
        PG8_WAIT_V(6); PG8_BAR;
    } else {
        PG8_STAGE(PG8_SB(0, 0), cB, voffB); PG8_STAGE(PG8_SA(0, 0), cA, voffA); PG8_STAGE(PG8_SB(0, 1), cB + hstep, voffB); PG8_STAGE(PG8_SA(0, 1), cA + hstep, voffA);
        if (wr == 1) PG8_BAR;
        PG8_WAIT_V(4); PG8_BAR;
        PG8_STAGE(PG8_SB(1, 0), cB + kstep, voffB); PG8_STAGE(PG8_SA(1, 0), cA + kstep, voffA); PG8_STAGE(PG8_SB(1, 1), cB + hstep + kstep, voffB);
        PG8_WAIT_V(6); PG8_BAR;
    }
    for (;;) {
        const bool has_next = S.next(ui + 1, nxt);
        const char* nA = has_next ? (const char*)g.A + (size_t)nxt.pm * tstep : cA; const char* nB = has_next ? (const char*)g.Bt + (size_t)nxt.pn * tstep : cB;
        for (int t = 0; t < nt; t += 2) {
            const bool last = (t == nt - 2);
            const char* a1 = cA + (size_t)(t + 1) * kstep;
            const char* a2 = last ? nA : cA + (size_t)(t + 2) * kstep; const char* b2 = last ? nB : cB + (size_t)(t + 2) * kstep;
            const char* a3 = a2 + kstep; const char* b3 = b2 + kstep;
            if (last && has_next) S.a_ready(nxt);
            if constexpr (SP2) {
            PG8_LDB(B0, 0, 0); PG8_LDB(B1, 0, 1); PG8_SCHED; PG8_LDA(At, 0, 0); PG8_STAGE(PG8_SA(1, 1), a1 + hstep, voffA);
            PG8_WAIT_V(8); PG8_WAIT_L(0); PG8_BAR; PG8_MMA(0, 0, At, B0); PG8_MMA(0, 1, At, B1); PG8_BAR; PG8_SCHED;
            PG8_LDA(At, 0, 1); PG8_STAGE(PG8_SB(0, 0), b2, voffB); PG8_STAGE(PG8_SB(0, 1), b2 + hstep, voffB); PG8_STAGE(PG8_SA(0, 0), a2, voffA);
            PG8_WAIT_V(8); PG8_WAIT_L(0); PG8_BAR; PG8_MMA(1, 0, At, B0); PG8_MMA(1, 1, At, B1); PG8_BAR; PG8_SCHED;
            PG8_LDB(B0, 1, 0); PG8_LDB(B1, 1, 1); PG8_SCHED; PG8_LDA(At, 1, 0); PG8_STAGE(PG8_SA(0, 1), a2 + hstep, voffA);
            PG8_WAIT_V(8); PG8_WAIT_L(0); PG8_BAR; PG8_MMA(0, 0, At, B0); PG8_MMA(0, 1, At, B1); PG8_BAR; PG8_SCHED;
            PG8_LDA(At, 1, 1); PG8_STAGE(PG8_SB(1, 0), b3, voffB); PG8_STAGE(PG8_SB(1, 1), b3 + hstep, voffB); PG8_STAGE(PG8_SA(1, 0), a3, voffA);
            PG8_WAIT_V(8); PG8_WAIT_L(0); PG8_BAR; PG8_MMA(1, 0, At, B0); PG8_MMA(1, 1, At, B1); PG8_BAR; PG8_SCHED;
            } else {
            PG8_LDB(B0, 0, 0); PG8_SCHED; PG8_LDA(At, 0, 0); PG8_STAGE(PG8_SA(1, 1), a1 + hstep, voffA);
            PG8_WAIT_L(8); PG8_BAR; PG8_WAIT_L(0); PG8_MMA(0, 0, At, B0); PG8_BAR; PG8_SCHED;
            PG8_LDB(B1, 0, 1); PG8_STAGE(PG8_SB(0, 0), b2, voffB);
            PG8_BAR; PG8_WAIT_L(0); PG8_MMA(0, 1, At, B1); PG8_BAR;
            PG8_LDA(At, 0, 1); PG8_STAGE(PG8_SA(0, 0), a2, voffA);
            PG8_BAR; PG8_WAIT_L(0); PG8_MMA(1, 0, At, B0); PG8_BAR; PG8_SCHED;
            PG8_STAGE(PG8_SB(0, 1), b2 + hstep, voffB);
            PG8_WAIT_V(6); PG8_BAR; PG8_MMA(1, 1, At, B1); PG8_BAR;
            PG8_LDB(B0, 1, 0); PG8_SCHED; PG8_LDA(At, 1, 0); PG8_STAGE(PG8_SA(0, 1), a2 + hstep, voffA);
            PG8_WAIT_L(8); PG8_BAR; PG8_WAIT_L(0); PG8_MMA(0, 0, At, B0); PG8_BAR; PG8_SCHED;
            PG8_LDB(B1, 1, 1); PG8_STAGE(PG8_SB(1, 0), b3, voffB);
            PG8_BAR; PG8_WAIT_L(0); PG8_MMA(0, 1, At, B1); PG8_BAR;
            PG8_LDA(At, 1, 1); PG8_STAGE(PG8_SA(1, 0), a3, voffA);
            PG8_BAR; PG8_WAIT_L(0); PG8_MMA(1, 0, At, B0); PG8_BAR; PG8_SCHED;
            PG8_STAGE(PG8_SB(1, 1), b3 + hstep, voffB);
            PG8_WAIT_V(6); PG8_BAR; PG8_MMA(1, 1, At, B1); PG8_BAR;
            }
        }
        if constexpr (ALIGN_EPI) { if (wr == 0) PG8_BAR; }
        if constexpr (!Epi::AFTER_DRAIN) { E(acc, cur, wr, wc, fr, fq); S.done(cur); }
        if (!has_next) break;
#pragma unroll
        for (int a = 0; a < 2; ++a)
#pragma unroll
            for (int b = 0; b < 2; ++b)
#pragma unroll
                for (int m = 0; m < 4; ++m)
#pragma unroll
                    for (int n = 0; n < 2; ++n) acc[a][b][m][n] = (f32x4){0.f, 0.f, 0.f, 0.f};
        cur = nxt; cA = nA; cB = nB; ++ui;
        if constexpr (ALIGN_EPI) { if (wr == 1) PG8_BAR; }
    }
    PG8_WAIT_V(0);
    if constexpr (!ALIGN_EPI) { if (wr == 0) PG8_BAR; }
    PG8_BAR;
    if constexpr (Epi::AFTER_DRAIN) { E.fused(acc, cur, wr, wc, fr, fq, lds, wid, lane); S.done(cur); }
#undef PG8_SA
#undef PG8_SB
#undef PG8_STAGE
#undef PG8_LDA
#undef PG8_LDB
#undef PG8_MMA
#undef PG8_WAIT_V
#undef PG8_WAIT_L
#undef PG8_BAR
#undef PG8_SCHED
}
}

#define PG8_SP2 true
#define PG8_ALIGN true
#define GAS __attribute__((address_space(1)))
#define LAS __attribute__((address_space(3)))
typedef unsigned short bf16;
typedef unsigned v4u __attribute__((ext_vector_type(4)));
typedef unsigned v2u __attribute__((ext_vector_type(2)));
typedef float f32x4 __attribute__((ext_vector_type(4)));
typedef short bf16x8 __attribute__((ext_vector_type(8)));
typedef GAS unsigned gu32;
#define RLX_AGENT __ATOMIC_RELAXED, __HIP_MEMORY_SCOPE_AGENT
#define LDS_WAIT() asm volatile("s_waitcnt lgkmcnt(0)" ::: "memory")
#define VM_WAIT() asm volatile("s_waitcnt vmcnt(0)" ::: "memory")
__device__ __forceinline__ unsigned f2bf(float f) { unsigned u = __builtin_bit_cast(unsigned, f); return (u + 0x7fffu + ((u >> 16) & 1u)) >> 16; }
__device__ __forceinline__ unsigned pk2(float lo, float hi) { return f2bf(lo) | (f2bf(hi) << 16); }
__device__ __forceinline__ float bf2f(unsigned short b) { return __builtin_bit_cast(float, (unsigned)b << 16); }

constexpr int NWAVES = 8;
constexpr int T = 16384, DM = 1024, NBATCH = 32, MROWS = 16640, RP = MROWS, FF = 4096;
constexpr int LIN = 6424, NIN = 6656;
constexpr int N_PHASES = 13;
#ifndef MK_ONE_LAUNCH
#define MK_ONE_LAUNCH 1
#endif
constexpr size_t O_Y = 0, O_YS = 16777216, O_CMPP = 16809984, O_SELP = 21004288, O_WINP = 25198592, O_STP = 25329664,
                 O_CMPS = 25460736, O_SELS = 25468928, O_WINS = 25477120, O_STS = 29671424, O_END = 33865728;
constexpr size_t al256(size_t x) { return (x + 255) & ~(size_t)255; }
constexpr size_t WS_CTL = 0, CTL_BYTES = (size_t)1 << 20;
constexpr size_t WS_WIN  = CTL_BYTES;
constexpr size_t WS_WBN  = WS_WIN  + al256((size_t)NIN * 1024 * 2);
constexpr size_t WS_WBR  = WS_WBN  + al256((size_t)1024 * 512 * 2);
constexpr size_t WS_WO   = WS_WBR  + al256((size_t)1024 * 1024 * 2);
constexpr size_t WS_WUP  = WS_WO   + al256((size_t)1024 * 1024 * 2);
constexpr size_t WS_WDN  = WS_WUP  + al256((size_t)4096 * 1024 * 2);
constexpr size_t WS_MOD  = WS_WDN  + al256((size_t)4096 * 1024 * 2);
constexpr size_t WS_COS64 = WS_MOD + al256((size_t)33 * 6144 * 4);
constexpr size_t WS_SIN64 = WS_COS64 + al256((size_t)16385 * 32 * 4);
constexpr size_t WS_COS128 = WS_SIN64 + al256((size_t)16385 * 32 * 4);
constexpr size_t WS_SIN128 = WS_COS128 + al256((size_t)16385 * 64 * 4);
constexpr size_t WS_GPOW = WS_SIN128 + al256((size_t)16385 * 64 * 4);
constexpr size_t WS_GINV = WS_GPOW + al256(4 * 132 * 4);
constexpr size_t WS_ST64 = WS_GINV + al256(4 * 132 * 4);
constexpr size_t WS_ST128 = WS_ST64 + 256;
constexpr size_t WS_H    = WS_ST128 + 512;
constexpr size_t WS_Q    = WS_H    + al256((size_t)MROWS * 1024 * 2);
constexpr size_t WS_KS   = WS_Q    + al256((size_t)MROWS * 512 * 2);
constexpr size_t WS_VST  = WS_KS   + al256((size_t)2 * RP * 64 * 2);
constexpr size_t WS_KW   = WS_VST  + al256((size_t)2 * RP * 64 * 2);
constexpr size_t WS_VWT  = WS_KW   + al256((size_t)2 * RP * 64 * 2);
constexpr size_t WS_GN   = WS_VWT  + al256((size_t)2 * RP * 64 * 2);
constexpr size_t WS_RQD  = WS_GN   + al256((size_t)MROWS * 24 * 4);
constexpr size_t WS_RKI  = WS_RQD  + al256((size_t)MROWS * 512 * 2);
constexpr size_t WS_RKIT = WS_RKI  + al256((size_t)MROWS * 512 * 2);
constexpr size_t WS_RVT  = WS_RKIT + al256((size_t)MROWS * 512 * 2);
constexpr size_t WS_SRG  = WS_RVT  + al256((size_t)MROWS * 1024 * 2);
constexpr size_t WS_SGA  = WS_SRG  + al256((size_t)MROWS * 1024 * 2);
constexpr size_t WS_SGB  = WS_SGA  + al256((size_t)MROWS * 1024 * 2);
constexpr size_t WS_CMPKP = WS_SGB + al256((size_t)MROWS * 1024 * 2);
constexpr size_t WS_CMPVP = WS_CMPKP + al256((size_t)2 * 1024 * 64 * 2);
constexpr size_t WS_CMPKS = WS_CMPVP + al256((size_t)2 * 1024 * 64 * 2);
constexpr size_t WS_CMPVS = WS_CMPKS + al256((size_t)64 * 1024 * 64 * 2);
constexpr size_t WS_U    = WS_CMPVS + al256((size_t)64 * 1024 * 64 * 2);
constexpr size_t WS_SPREV = WS_U   + al256((size_t)128 * 131072 * 4);
constexpr size_t WS_ONSA = WS_SPREV + al256((size_t)128 * 131072 * 2);
constexpr size_t WS_YRET = WS_ONSA + al256((size_t)MROWS * 512 * 2);
constexpr size_t WS_MIXA = WS_YRET + al256((size_t)MROWS * 1024 * 2);
constexpr size_t WS_MIXED = WS_MIXA + al256((size_t)MROWS * 1024 * 4);
constexpr size_t WS_X1   = WS_MIXED + al256((size_t)MROWS * 1024 * 2);
constexpr size_t WS_UP   = WS_X1   + al256((size_t)MROWS * 1024 * 4);
constexpr size_t WS_H2   = WS_UP   + al256((size_t)MROWS * 4096 * 2);
constexpr size_t WS_X2   = WS_H2   + al256((size_t)MROWS * 1024 * 2);
constexpr size_t WS_STASH = WS_X2  + al256((size_t)MROWS * 1024 * 4);
constexpr size_t WS_END  = WS_STASH + al256((size_t)2048 * 512 * 16);
constexpr int CW_BAR = 4096;
constexpr int RING_BYTES = 131072, MISC_OFF = 143360, LDS_BYTES = 147456;

constexpr float QSCALE = 0.125f * 1.4426950408889634f;
constexpr float RK_SCALE = 0.08838834764831845f;

typedef pg8::f32x4 f4;
__device__ __forceinline__ unsigned cvtpk(float lo, float hi) { unsigned r; asm("v_cvt_pk_bf16_f32 %0, %1, %2" : "=v"(r) : "v"(lo), "v"(hi)); return r; }
__device__ __forceinline__ v4u pack8u(const f4& a, const f4& b) { v4u w; w.x = cvtpk(a[0], a[1]); w.y = cvtpk(a[2], a[3]); w.z = cvtpk(b[0], b[1]); w.w = cvtpk(b[2], b[3]); return w; }
__device__ __forceinline__ bf16x8 pack8(const f4& a, const f4& b) { return __builtin_bit_cast(bf16x8, pack8u(a, b)); }
__device__ __forceinline__ unsigned short bf1(float x) { return (unsigned short)(cvtpk(x, x) & 0xffffu); }
__device__ __forceinline__ float fexp2(float x) { return __builtin_amdgcn_exp2f(x); }
__device__ __forceinline__ int lane_id() { int x; asm volatile("v_mbcnt_lo_u32_b32 %0, -1, 0\n\tv_mbcnt_hi_u32_b32 %0, -1, %0" : "=v"(x)); return x; }
__device__ __forceinline__ int launder_v(int x) { asm volatile("" : "+v"(x)); return x; }
template <class P> __device__ __forceinline__ P* launder_p(P* p) { unsigned long long v = (unsigned long long)p; asm volatile("" : "+s"(v)); return (P*)v; }
__device__ __forceinline__ int launder_s(int x) { x = __builtin_amdgcn_readfirstlane(x); asm volatile("" : "+s"(x)); return x; }
__device__ __forceinline__ float sigmoidf_(float x) { return __builtin_amdgcn_rcpf(1.0f + __expf(-x)); }
__device__ __forceinline__ float wave_sum(float v) {
#pragma unroll
    for (int o = 1; o < 64; o <<= 1) v += __shfl_xor(v, o);
    return v;
}
#define MFMA16(a, b, c) __builtin_amdgcn_mfma_f32_16x16x32_bf16((a), (b), (c), 0, 0, 0)
#define WAVE_SYNC() do { __builtin_amdgcn_wave_barrier(); asm volatile("s_waitcnt lgkmcnt(0)" ::: "memory"); __builtin_amdgcn_wave_barrier(); } while (0)

struct Ctx {
    LAS unsigned char* lds;
    int tid, lane, wave, bid, nb, gw, ngw;
    const float* in[24]; float* out; unsigned char* ws;
};
#define WSP(type, off) ((type*)(C.ws + (off)))

__device__ __forceinline__ void transpose_item(const float* W, int K, int N, bf16* WT, int kb, int src_col0, int ncols, int dst_row0, LAS float* scr, int lane) {
    const int k0 = 64 * kb;
    float tv[32];
#pragma unroll
    for (int i = 0; i < 32; ++i) { const int kk = 2 * i + (lane >> 5); const int cn = lane & 31;
        tv[i] = (cn < ncols) ? __builtin_nontemporal_load(W + (size_t)(k0 + kk) * N + src_col0 + cn) : 0.f; }
#pragma unroll
    for (int i = 0; i < 32; ++i) { const int kk = 2 * i + (lane >> 5); const int cn = lane & 31; scr[kk * 33 + cn] = tv[i]; }
    WAVE_SYNC();
    const int c = lane & 7;
#pragma unroll
    for (int j = 0; j < 4; ++j) { const int n = (lane >> 3) + 8 * j; const LAS float* s = scr + (8 * c) * 33 + n;
        v4u o; o.x = pk2(s[0 * 33], s[1 * 33]); o.y = pk2(s[2 * 33], s[3 * 33]); o.z = pk2(s[4 * 33], s[5 * 33]); o.w = pk2(s[6 * 33], s[7 * 33]);
        *(GAS v4u*)(WT + (size_t)(dst_row0 + n) * K + k0 + 8 * c) = o; }
    WAVE_SYNC();
}
__device__ __forceinline__ int win_src_col(int pb, int& ncols) {
    const int tile = pb >> 3, blk = pb & 7, bj = blk >> 2, wcb = blk & 3; ncols = 32;
    if (tile < 2)  return 256 * tile + 64 * wcb + 32 * bj;
    if (tile < 5)  return 512 + 256 * (tile - 2) + 64 * wcb + 32 * bj;
    if (tile < 7)  return 1304 + 256 * (tile - 5) + 128 * (wcb >> 1) + 64 * bj + 32 * (wcb & 1);
    if (tile < 9)  return 1816 + 256 * (tile - 7) + 128 * (wcb >> 1) + 64 * bj + 32 * (wcb & 1);
    if (tile < 13) return 2328 + 256 * (tile - 9) + 32 * blk;
    if (tile < 17) return 3352 + 256 * (tile - 13) + 32 * blk;
    if (tile < 21) return 4376 + 256 * (tile - 17) + 32 * blk;
    if (tile < 25) return 5400 + 256 * (tile - 21) + 32 * blk;
    if (blk == 0) { ncols = 24; return 1280; }
    ncols = 0; return 0;
}

__device__ __forceinline__ void cmp_build_page(const float* base0, const float* base1, const LAS float* wl, const float* b_cmp, bf16* Kd, bf16* VTd, int p, int lane) {
    const int ch = 4 * lane, c = ch >> 7, h = (ch >> 6) & 1, d = ch & 63;
    const LAS float* wp = wl + ((c * 2 + h) * 32) * 64 + d;
    const f4 bias = *(const f4*)(b_cmp + (c * 2 + h) * 64 + d);
    f4 acc[8];
#pragma unroll
    for (int n = 0; n < 8; ++n) acc[n] = bias;
    const int nstr = base1 ? 9 : 8;
#pragma unroll
    for (int n = 0; n < 9; ++n) {
        if (n < nstr) {
            const float* rb = (n < 8) ? base0 + (size_t)(16 * n) * 256 + ch : base1 + ch;
            f4 x[16];
#pragma unroll
            for (int jj = 0; jj < 16; ++jj) x[jj] = __builtin_nontemporal_load((const f4*)(rb + (size_t)jj * 256));
#pragma unroll
            for (int jj = 0; jj < 16; ++jj) {
                if (n < 8) acc[n < 8 ? n : 0] += *(const LAS f4*)(wp + jj * 64) * x[jj];
                if (n > 0) acc[n > 0 ? n - 1 : 0] += *(const LAS f4*)(wp + (16 + jj) * 64) * x[jj];
            }
        }
    }
    if (!base1) acc[7] = (f4){0.f, 0.f, 0.f, 0.f};
    if (c == 0) {
#pragma unroll
        for (int n = 0; n < 8; ++n) { v2u w; w.x = cvtpk(acc[n][0], acc[n][1]); w.y = cvtpk(acc[n][2], acc[n][3]); *(v2u*)(Kd + ((size_t)h * 1024 + 8 * p + n) * 64 + d) = w; }
    } else {
#pragma unroll
        for (int q = 0; q < 4; ++q) { v4u w; w.x = cvtpk(acc[0][q], acc[1][q]); w.y = cvtpk(acc[2][q], acc[3][q]); w.z = cvtpk(acc[4][q], acc[5][q]); w.w = cvtpk(acc[6][q], acc[7][q]);
            *(v4u*)(VTd + ((size_t)h * 64 + d + q) * 1024 + 8 * p) = w; }
    }
}
__device__ __forceinline__ void stage_wcmp(Ctx& C) {
    LAS f4* wl = (LAS f4*)C.lds; const f4* src = (const f4*)C.in[15];
    __syncthreads();
    { f4 t[4];
#pragma unroll
      for (int i = 0; i < 4; ++i) t[i] = src[C.tid + 512 * i];
#pragma unroll
      for (int i = 0; i < 4; ++i) wl[C.tid + 512 * i] = t[i]; }
    __syncthreads();
}

__device__ __forceinline__ double gamma_h(int h) { return 1.0 - exp2(-5.0 - (double)h); }

__device__ __forceinline__ void phase0(Ctx& C, int mask) {
    const float* c_prompt = C.in[2]; const float* c_sample = C.in[3];
    const float* w_ada = C.in[12]; const float* b_ada = C.in[13];
    float* MOD = WSP(float, WS_MOD);
    if (mask & 1) {
        LAS float* sil = (LAS float*)(C.lds + C.wave * 16384);
        LAS float* red = (LAS float*)(C.lds);
        for (int task = C.bid; task < 192; task += C.nb) {
            const int col = 32 * task + (C.lane & 31), kh = C.lane >> 5;
#pragma unroll 1
            for (int half = 0; half < 2; ++half) {
                const int r0 = half * 17, nr = half ? 16 : 17;
#pragma unroll 1
                for (int i0 = 0; i0 < 34; i0 += 17) {
                    float cvv[17];
#pragma unroll
                    for (int i = 0; i < 17; ++i) { const int e = C.lane + 64 * (i0 + i), rr = e >> 7, kk = e & 127, r = r0 + rr, k = 128 * C.wave + kk;
                        cvv[i] = (e < nr * 128) ? ((r == 0) ? c_prompt[k] : c_sample[(size_t)(r - 1) * 1024 + k]) : 0.f; }
#pragma unroll
                    for (int i = 0; i < 17; ++i) { const int e = C.lane + 64 * (i0 + i); if (e < nr * 128) sil[e] = cvv[i] * sigmoidf_(cvv[i]); } }
                WAVE_SYNC();
                float acc[17];
#pragma unroll
                for (int r = 0; r < 17; ++r) acc[r] = 0.f;
#pragma unroll 8
                for (int k4 = 0; k4 < 16; ++k4) { const int kl = 64 * kh + 4 * k4; float wv[4];
#pragma unroll
                    for (int q = 0; q < 4; ++q) wv[q] = w_ada[(size_t)(128 * C.wave + kl + q) * 6144 + col];
#pragma unroll
                    for (int r = 0; r < 17; ++r) { const f4 s4 = *(const LAS f4*)(sil + r * 128 + kl); acc[r] += (s4[0] * wv[0] + s4[1] * wv[1]) + (s4[2] * wv[2] + s4[3] * wv[3]); } }
#pragma unroll
                for (int r = 0; r < 17; ++r) acc[r] += __shfl_xor(acc[r], 32);
                __syncthreads();
                if (C.lane < 32) {
#pragma unroll
                    for (int r = 0; r < 17; ++r) red[(C.wave * 17 + r) * 32 + C.lane] = acc[r];
                }
                __syncthreads();
                for (int e = C.tid; e < nr * 32; e += 512) { const int rr = e >> 5, cc = e & 31; float s = 0.f;
#pragma unroll
                    for (int w = 0; w < 8; ++w) s += red[(w * 17 + rr) * 32 + cc];
                    MOD[(size_t)(r0 + rr) * 6144 + 32 * task + cc] = s + b_ada[32 * task + cc]; }
                __syncthreads();
            }
        }
    }
    if (mask & 2) {
        LAS float* scr = (LAS float*)(C.lds + C.wave * 16384);
        constexpr int I_IN = 16 * 208, I_BN = 8 * 32, I_BR = 16 * 32, I_O = 16 * 32, I_UP = 16 * 128, I_DN = 64 * 32;
        constexpr int NIT = I_IN + I_BN + I_BR + I_O + I_UP + I_DN;
        for (int it = C.gw; it < NIT; it += C.ngw) {
            int r = it;
            if (r < I_IN) { const int kb = r / 208, pb = r % 208; int nc; const int sc = win_src_col(pb, nc);
                transpose_item(C.in[14], 1024, LIN, WSP(bf16, WS_WIN), kb, sc, nc, 32 * pb, scr, C.lane); continue; } r -= I_IN;
            if (r < I_BN) { transpose_item(C.in[19], 512, 1024, WSP(bf16, WS_WBN), r / 32, 32 * (r % 32), 32, 32 * (r % 32), scr, C.lane); continue; } r -= I_BN;
            if (r < I_BR) { transpose_item(C.in[20], 1024, 1024, WSP(bf16, WS_WBR), r / 32, 32 * (r % 32), 32, 32 * (r % 32), scr, C.lane); continue; } r -= I_BR;
            if (r < I_O)  { transpose_item(C.in[21], 1024, 1024, WSP(bf16, WS_WO), r / 32, 32 * (r % 32), 32, 32 * (r % 32), scr, C.lane); continue; } r -= I_O;
            if (r < I_UP) { transpose_item(C.in[22], 1024, 4096, WSP(bf16, WS_WUP), r / 128, 32 * (r % 128), 32, 32 * (r % 128), scr, C.lane); continue; } r -= I_UP;
            transpose_item(C.in[23], 4096, 1024, WSP(bf16, WS_WDN), r / 32, 32 * (r % 32), 32, 32 * (r % 32), scr, C.lane);
        }
    }
    if (mask & 4) {
        const int gt = C.bid * 512 + C.tid, ngt = C.nb * 512;
        float* c64 = WSP(float, WS_COS64); float* s64 = WSP(float, WS_SIN64); float* c128 = WSP(float, WS_COS128); float* s128 = WSP(float, WS_SIN128);
        constexpr double TWO_PI = 6.283185307179586476925, INV_2PI = 0.15915494309189533577;
        { const float inv = (float)pow(10000.0, -(double)(2 * (gt & 31)) / 64.0);
          for (int e = gt; e < 16385 * 32; e += ngt) { const int pos = e >> 5; const float ang = (float)pos * inv;
            const double q = rint((double)ang * INV_2PI); const float r = (float)fma(-q, TWO_PI, (double)ang);
            c64[e] = cosf(r); s64[e] = sinf(r); } }
        { const float inv = (float)pow(10000.0, -(double)(2 * (gt & 63)) / 128.0);
          for (int e = gt; e < 16385 * 64; e += ngt) { const int pos = e >> 6; const float ang = (float)pos * inv;
            const double q = rint((double)ang * INV_2PI); const float r = (float)fma(-q, TWO_PI, (double)ang);
            c128[e] = cosf(r); s128[e] = sinf(r); } }
        { float* st64 = WSP(float, WS_ST64); float* st128 = WSP(float, WS_ST128);
          for (int e = gt; e < 32; e += ngt) { const float inv = (float)pow(10000.0, -(double)(2 * e) / 64.0); st64[e] = (float)cos(16.0 * (double)inv); st64[32 + e] = (float)sin(16.0 * (double)inv); }
          for (int e = gt; e < 64; e += ngt) { const float inv = (float)pow(10000.0, -(double)(2 * e) / 128.0); st128[e] = (float)cos(16.0 * (double)inv); st128[64 + e] = (float)sin(16.0 * (double)inv); } }
        float* gp = WSP(float, WS_GPOW); float* gi = WSP(float, WS_GINV);
        for (int e = gt; e < 4 * 132; e += ngt) { const int h = e / 132, n = e % 132; const double lg = log(gamma_h(h));
            gp[e] = (float)exp((double)n * lg); gi[e] = (float)exp(-(double)n * lg); }
        unsigned* hz = (unsigned*)(WSP(bf16, WS_H) + (size_t)(T + NBATCH) * 1024);
        for (int e = gt; e < (MROWS - T - NBATCH) * 512; e += ngt) hz[e] = 0u;
    }
    if (mask & 8) {
        const float* cw = C.in[6];
#pragma unroll 1
        for (int rr0 = C.gw; rr0 < NBATCH * 511; rr0 += 8 * C.ngw) { f4 v[8];
#pragma unroll
            for (int q = 0; q < 8; ++q) { const int rr = rr0 + q * C.ngw; const int b = rr / 511, j = rr % 511;
                if (rr < NBATCH * 511) v[q] = __builtin_nontemporal_load((const f4*)(cw + ((size_t)b * 512 + j + 1) * 256) + C.lane); }
#pragma unroll
            for (int q = 0; q < 8; ++q) { const int rr = rr0 + q * C.ngw; const int b = rr / 511, j = rr % 511;
                if (rr < NBATCH * 511) *((f4*)(C.out + O_WINS + ((size_t)b * 512 + j) * 256) + C.lane) = v[q]; } }
    }
    if (mask & 16) {
        const float* cc = C.in[4]; const int* pt = (const int*)C.in[8];
        stage_wcmp(C);
        for (int task = C.gw; task < NBATCH * 128; task += C.ngw) { const int b = task >> 7, p = task & 127;
            const int ph0 = pt[b * 128 + p]; const int ph1 = (p < 127) ? pt[b * 128 + p + 1] : 0;
            const float* base0 = cc + (size_t)ph0 * 128 * 256; const float* base1 = (p < 127) ? cc + (size_t)ph1 * 128 * 256 : nullptr;
            cmp_build_page(base0, base1, (const LAS float*)C.lds, C.in[16], WSP(bf16, WS_CMPKS) + (size_t)b * 2 * 65536, WSP(bf16, WS_CMPVS) + (size_t)b * 2 * 65536, p, C.lane); }
    }
}

__device__ __forceinline__ void late_prologue(Ctx& C, int iw, int niw) {
    LAS float* scr = (LAS float*)(C.lds + C.wave * 16384);
    const float* cw = C.in[6];
    constexpr int I_BN = 8 * 32, I_BR = 16 * 32, I_O = 16 * 32, I_UP = 16 * 128, I_DN = 64 * 32, NTR = I_BN + I_BR + I_O + I_UP + I_DN, NWIN = (NBATCH * 511) / 8;
#pragma unroll 1
    for (int t = NTR + iw; t < NTR + NWIN; t += niw) {
        const int ll = launder_v(C.lane);
        if (t < NTR) { int r = t;
            if (r < I_BN) { transpose_item(C.in[19], 512, 1024, WSP(bf16, WS_WBN), r / 32, 32 * (r % 32), 32, 32 * (r % 32), scr, ll); continue; } r -= I_BN;
            if (r < I_BR) { transpose_item(C.in[20], 1024, 1024, WSP(bf16, WS_WBR), r / 32, 32 * (r % 32), 32, 32 * (r % 32), scr, ll); continue; } r -= I_BR;
            if (r < I_O)  { transpose_item(C.in[21], 1024, 1024, WSP(bf16, WS_WO), r / 32, 32 * (r % 32), 32, 32 * (r % 32), scr, ll); continue; } r -= I_O;
            if (r < I_UP) { transpose_item(C.in[22], 1024, 4096, WSP(bf16, WS_WUP), r / 128, 32 * (r % 128), 32, 32 * (r % 128), scr, ll); continue; } r -= I_UP;
            transpose_item(C.in[23], 4096, 1024, WSP(bf16, WS_WDN), r / 32, 32 * (r % 32), 32, 32 * (r % 32), scr, ll);
        } else { const int rr0 = 8 * (t - NTR); f4 v[8];
#pragma unroll
            for (int k = 0; k < 8; ++k) { const int rr = rr0 + k; const int b = rr / 511, j = rr % 511; v[k] = __builtin_nontemporal_load((const f4*)(cw + ((size_t)b * 512 + j + 1) * 256) + ll); }
#pragma unroll
            for (int k = 0; k < 8; ++k) { const int rr = rr0 + k; const int b = rr / 511, j = rr % 511; *((f4*)(C.out + O_WINS + ((size_t)b * 512 + j) * 256) + ll) = v[k]; }
        }
    }
}

template <bool OUT_BF16, bool NT_IN = false, bool NT_OUT = false>
__device__ __forceinline__ void rmsnorm_row(const float* src, const float* g, const float* sh, const float* sc, void* dst, int lane) {
    const f4* xr = (const f4*)src + lane;
    f4 v[4]; float ss = 0.f;
#pragma unroll
    for (int j = 0; j < 4; ++j) { v[j] = NT_IN ? __builtin_nontemporal_load(xr + 64 * j) : xr[64 * j]; ss += (v[j][0] * v[j][0] + v[j][1] * v[j][1]) + (v[j][2] * v[j][2] + v[j][3] * v[j][3]); }
    const float rstd = 1.0f / sqrtf(wave_sum(ss) * (1.0f / 1024.0f) + 1e-6f);
#pragma unroll
    for (int j = 0; j < 4; ++j) {
        const int k = 4 * lane + 256 * j;
        f4 y = v[j] * rstd * *(const f4*)(g + k);
        if (sc) y = y * (*(const f4*)(sc + k) + 1.0f) + *(const f4*)(sh + k);
        if (OUT_BF16) { v2u w; w.x = cvtpk(y[0], y[1]); w.y = cvtpk(y[2], y[3]); *(v2u*)((bf16*)dst + k) = w; }
        else { if (NT_OUT) __builtin_nontemporal_store(y, (f4*)((float*)dst + k)); else *(f4*)((float*)dst + k) = y; }
    }
}

template <bool OUT_BF16, bool NT_IN, bool NT_OUT>
__device__ __forceinline__ void rmsnorm_rows4(const float* src, size_t spitch, const float* g, const float* sh, const float* sc, void* dst, size_t dpitch, int lane) {
    f4 v[4][4]; float ss[4];
#pragma unroll
    for (int q = 0; q < 4; ++q) { const f4* xr = (const f4*)(src + (size_t)q * spitch) + lane;
#pragma unroll
        for (int j = 0; j < 4; ++j) v[q][j] = NT_IN ? __builtin_nontemporal_load(xr + 64 * j) : xr[64 * j]; }
#pragma unroll
    for (int q = 0; q < 4; ++q) { float a = 0.f;
#pragma unroll
        for (int j = 0; j < 4; ++j) a += (v[q][j][0] * v[q][j][0] + v[q][j][1] * v[q][j][1]) + (v[q][j][2] * v[q][j][2] + v[q][j][3] * v[q][j][3]);
        ss[q] = a; }
#pragma unroll
    for (int q = 0; q < 4; ++q) ss[q] = 1.0f / sqrtf(wave_sum(ss[q]) * (1.0f / 1024.0f) + 1e-6f);
#pragma unroll
    for (int j = 0; j < 4; ++j) {
        const int k = 4 * lane + 256 * j;
        const f4 gv = *(const f4*)(g + k); f4 scv = {1.f, 1.f, 1.f, 1.f}, shv = {0.f, 0.f, 0.f, 0.f};
        if (sc) { scv = *(const f4*)(sc + k) + 1.0f; shv = *(const f4*)(sh + k); }
#pragma unroll
        for (int q = 0; q < 4; ++q) {
            f4 y = v[q][j] * ss[q] * gv;
            if (sc) y = y * scv + shv;
            if (OUT_BF16) { v2u w; w.x = cvtpk(y[0], y[1]); w.y = cvtpk(y[2], y[3]); *(v2u*)((bf16*)dst + (size_t)q * dpitch + k) = w; }
            else { if (NT_OUT) __builtin_nontemporal_store(y, (f4*)((float*)dst + (size_t)q * dpitch + k)); else *(f4*)((float*)dst + (size_t)q * dpitch + k) = y; }
        }
    }
}
struct EpiIn {
    static constexpr bool PERM = true, AFTER_DRAIN = false;
    unsigned char* ws; float* out;
    __device__ __forceinline__ void operator()(const f4 (&acc)[2][2][4][2], const pg8::Unit& u, int wr, int wc, int fr, int fq) const { run<2, 4>(acc, u, wr, wc, fr, fq); }
    __device__ __forceinline__ void run_main(const f4 (&acc)[2][2][4][2], const pg8::Unit& u, int wr, int wc, int fr, int fq) const {
        const int tile = u.pn, r0 = u.pm * 256 + wr * 64 + fr;
        if (tile < 5) {
            const bool rope = (tile < 2) || (wc < 2);
            f4 dc[2], ds[2];
            { const float* st = (const float*)(ws + WS_ST64) + 8 * fq; dc[0] = *(const f4*)st; dc[1] = *(const f4*)(st + 4); ds[0] = *(const f4*)(st + 32); ds[1] = *(const f4*)(st + 36); }
#pragma unroll
            for (int ai = 0; ai < 2; ++ai) { f4 c0, c1, s0, s1;
                { const float* cp = (const float*)(ws + WS_COS64) + (size_t)(r0 + 128 * ai) * 32 + 8 * fq; const float* sp = (const float*)(ws + WS_SIN64) + (size_t)(r0 + 128 * ai) * 32 + 8 * fq;
                  c0 = *(const f4*)cp; c1 = *(const f4*)(cp + 4); s0 = *(const f4*)sp; s1 = *(const f4*)(sp + 4); }
#pragma unroll
                for (int m = 0; m < 4; ++m) { const int r = r0 + 128 * ai + 16 * m;
                    const f4 a0 = acc[ai][0][m][0], a1 = acc[ai][0][m][1], b0 = acc[ai][1][m][0], b1 = acc[ai][1][m][1];
                    f4 o10 = a0, o11 = a1, o20 = b0, o21 = b1;
                    if (rope) { o10 = a0 * c0 - b0 * s0; o11 = a1 * c1 - b1 * s1; o20 = a0 * s0 + b0 * c0; o21 = a1 * s1 + b1 * c1; }
                    if (tile < 2) {
                        bf16* q = (bf16*)(ws + WS_Q) + ((size_t)r * 8 + 4 * tile + wc) * 64 + 8 * fq;
                        *(v4u*)q = pack8u(o10 * QSCALE, o11 * QSCALE); *(v4u*)(q + 32) = pack8u(o20 * QSCALE, o21 * QSCALE);
                    } else {
                        const int c_ = wc >> 1, h = wc & 1;
                        float* dst = nullptr;
                        if (tile == 2) dst = out + O_CMPP + (size_t)r * 256;
                        else if (tile == 3) dst = out + O_SELP + (size_t)r * 256;
                        else dst = (r >= T - 512) ? out + O_WINP + (size_t)(r - (T - 512)) * 256 : nullptr;
                        if (dst) { float* d0 = dst + c_ * 128 + h * 64 + 8 * fq; *(f4*)d0 = o10; *(f4*)(d0 + 4) = o11; *(f4*)(d0 + 32) = o20; *(f4*)(d0 + 36) = o21; }
                        if (tile >= 3) {
                            if (c_ == 0) { bf16* kd = (bf16*)(ws + (tile == 3 ? WS_KS : WS_KW)) + ((size_t)h * RP + r) * 64 + 8 * fq;
                                *(v4u*)kd = pack8u(o10, o11); *(v4u*)(kd + 32) = pack8u(o20, o21); }
                            else { bf16* vd = (bf16*)(ws + (tile == 3 ? WS_VST : WS_VWT)) + ((size_t)(h * 64 + 8 * fq)) * RP + r;
#pragma unroll
                                for (int j = 0; j < 4; ++j) { vd[(size_t)j * RP] = bf1(o10[j]); vd[(size_t)(4 + j) * RP] = bf1(o11[j]);
                                    vd[(size_t)(32 + j) * RP] = bf1(o20[j]); vd[(size_t)(36 + j) * RP] = bf1(o21[j]); } }
                        }
                    }
                    if (m < 3) { const f4 n0 = c0 * dc[0] - s0 * ds[0], n1 = c1 * dc[1] - s1 * ds[1]; s0 = s0 * dc[0] + c0 * ds[0]; s1 = s1 * dc[1] + c1 * ds[1]; c0 = n0; c1 = n1; }
                } }
        } else if (tile < 9) {
            const bool isk = tile >= 7; const int head = 2 * ((tile - 5) & 1) + (wc >> 1), dd0 = 32 * (wc & 1) + 8 * fq;
            f4 dc[2], ds[2]; float sclm[4];
            { const float* st = (const float*)(ws + WS_ST128) + dd0; dc[0] = *(const f4*)st; dc[1] = *(const f4*)(st + 4); ds[0] = *(const f4*)(st + 64); ds[1] = *(const f4*)(st + 68); }
#pragma unroll
            for (int m = 0; m < 4; ++m) sclm[m] = (isk ? RK_SCALE : 1.0f) * ((const float*)(ws + (isk ? WS_GINV : WS_GPOW)))[head * 132 + ((r0 + 16 * m) & 127) + 1];
#pragma unroll
            for (int ai = 0; ai < 2; ++ai) { f4 c0, c1, s0, s1;
                { const float* cp = (const float*)(ws + WS_COS128) + (size_t)(r0 + 128 * ai) * 64 + dd0; const float* sp = (const float*)(ws + WS_SIN128) + (size_t)(r0 + 128 * ai) * 64 + dd0;
                  c0 = *(const f4*)cp; c1 = *(const f4*)(cp + 4); s0 = *(const f4*)sp; s1 = *(const f4*)(sp + 4); }
#pragma unroll
                for (int m = 0; m < 4; ++m) { const int r = r0 + 128 * ai + 16 * m; const float scl = sclm[m];
                    const f4 a0 = acc[ai][0][m][0], a1 = acc[ai][0][m][1], b0 = acc[ai][1][m][0], b1 = acc[ai][1][m][1];
                    const f4 o10 = (a0 * c0 - b0 * s0) * scl, o11 = (a1 * c1 - b1 * s1) * scl, o20 = (a0 * s0 + b0 * c0) * scl, o21 = (a1 * s1 + b1 * c1) * scl;
                    bf16* nd = (bf16*)(ws + (isk ? WS_RKI : WS_RQD)) + ((size_t)r * 4 + head) * 128 + dd0;
                    *(v4u*)nd = pack8u(o10, o11); *(v4u*)(nd + 64) = pack8u(o20, o21);
                    if (isk) { bf16* td = (bf16*)(ws + WS_RKIT) + ((size_t)(head * 128 + dd0)) * RP + r;
#pragma unroll
                        for (int j = 0; j < 4; ++j) { td[(size_t)j * RP] = bf1(o10[j]); td[(size_t)(4 + j) * RP] = bf1(o11[j]);
                            td[(size_t)(64 + j) * RP] = bf1(o20[j]); td[(size_t)(68 + j) * RP] = bf1(o21[j]); } }
                    if (m < 3) { const f4 n0 = c0 * dc[0] - s0 * ds[0], n1 = c1 * dc[1] - s1 * ds[1]; s0 = s0 * dc[0] + c0 * ds[0]; s1 = s1 * dc[1] + c1 * ds[1]; c0 = n0; c1 = n1; }
                } }
        } else {
#pragma unroll
            for (int ai = 0; ai < 2; ++ai)
#pragma unroll
                for (int m = 0; m < 4; ++m) { const int r = r0 + 128 * ai + 16 * m;
                    const f4 a0 = acc[ai][0][m][0], a1 = acc[ai][0][m][1], b0 = acc[ai][1][m][0], b1 = acc[ai][1][m][1];
                    if (tile < 13) {
                        bf16* td = (bf16*)(ws + WS_RVT) + ((size_t)((tile - 9) * 256 + 32 * wc + 8 * fq)) * RP + r;
#pragma unroll
                        for (int j = 0; j < 4; ++j) { td[(size_t)j * RP] = bf1(a0[j]); td[(size_t)(4 + j) * RP] = bf1(a1[j]);
                            td[(size_t)(128 + j) * RP] = bf1(b0[j]); td[(size_t)(132 + j) * RP] = bf1(b1[j]); }
                    } else if (tile < 25) {
                        const int t4 = (tile - 13) >> 2; bf16* dst = (bf16*)(ws + (t4 == 0 ? WS_SRG : (t4 == 1 ? WS_SGA : WS_SGB))) + (size_t)r * 1024 + 256 * ((tile - 13) & 3) + 32 * wc + 8 * fq;
                        f4 x0, x1, y0, y1;
#pragma unroll
                        for (int j = 0; j < 4; ++j) { const float g0 = sigmoidf_(a0[j]), g1 = sigmoidf_(a1[j]), g2 = sigmoidf_(b0[j]), g3 = sigmoidf_(b1[j]);
                            x0[j] = t4 == 0 ? a0[j] * g0 : g0; x1[j] = t4 == 0 ? a1[j] * g1 : g1; y0[j] = t4 == 0 ? b0[j] * g2 : g2; y1[j] = t4 == 0 ? b1[j] * g3 : g3; }
                        *(v4u*)dst = pack8u(x0, x1); *(v4u*)(dst + 128) = pack8u(y0, y1);
                    } else {
                        if (wc == 0 && fq < 3) { float* gd = (float*)(ws + WS_GN) + (size_t)r * 24 + 8 * fq; f4 x0, x1;
#pragma unroll
                            for (int j = 0; j < 4; ++j) { x0[j] = sigmoidf_(a0[j]); x1[j] = sigmoidf_(a1[j]); }
                            *(f4*)gd = x0; *(f4*)(gd + 4) = x1; }
                    }
                }
        }
    }
    template <int NAI, int NM> __device__ __forceinline__ void run(const f4 (&acc)[2][2][4][2], const pg8::Unit& u, int wr, int wc, int fr, int fq) const {
        if constexpr (NAI == 2 && NM == 4) { run_main(acc, u, wr, wc, fr, fq); return; }
        const int tile = u.pn;
#pragma unroll
        for (int ai = 0; ai < NAI; ++ai)
#pragma unroll
            for (int m = 0; m < NM; ++m) {
                const int r = u.pm * 256 + ai * 128 + wr * 64 + m * 16 + fr;
                const bool is_p = r < T; const int b = r - T; const bool is_s = (!is_p) && b < NBATCH;
                const int pos = is_p ? r : T;
                const f4 a0 = acc[ai][0][m][0], a1 = acc[ai][0][m][1], b0 = acc[ai][1][m][0], b1 = acc[ai][1][m][1];
                if (tile < 5) {
                    const bool rope = (tile < 2) || (wc < 2);
                    f4 o10 = a0, o11 = a1, o20 = b0, o21 = b1;
                    if (rope) {
                        const float* cp = (const float*)(ws + WS_COS64) + (size_t)pos * 32 + 8 * fq; const float* sp = (const float*)(ws + WS_SIN64) + (size_t)pos * 32 + 8 * fq;
                        const f4 c0 = *(const f4*)cp, c1 = *(const f4*)(cp + 4), s0 = *(const f4*)sp, s1 = *(const f4*)(sp + 4);
                        o10 = a0 * c0 - b0 * s0; o11 = a1 * c1 - b1 * s1; o20 = a0 * s0 + b0 * c0; o21 = a1 * s1 + b1 * c1;
                    }
                    if (tile < 2) {
                        bf16* q = (bf16*)(ws + WS_Q) + ((size_t)r * 8 + 4 * tile + wc) * 64 + 8 * fq;
                        *(v4u*)q = pack8u(o10 * QSCALE, o11 * QSCALE); *(v4u*)(q + 32) = pack8u(o20 * QSCALE, o21 * QSCALE);
                    } else {
                        const int c_ = wc >> 1, h = wc & 1;
                        float* dst = nullptr;
                        if (tile == 2) dst = is_p ? out + O_CMPP + (size_t)r * 256 : (is_s ? out + O_CMPS + (size_t)b * 256 : nullptr);
                        else if (tile == 3) dst = is_p ? out + O_SELP + (size_t)r * 256 : (is_s ? out + O_SELS + (size_t)b * 256 : nullptr);
                        else dst = (is_p && r >= T - 512) ? out + O_WINP + (size_t)(r - (T - 512)) * 256 : (is_s ? out + O_WINS + ((size_t)b * 512 + 511) * 256 : nullptr);
                        if (dst) { float* d0 = dst + c_ * 128 + h * 64 + 8 * fq; *(f4*)d0 = o10; *(f4*)(d0 + 4) = o11; *(f4*)(d0 + 32) = o20; *(f4*)(d0 + 36) = o21; }
                        if (tile >= 3) {
                            if (c_ == 0) { bf16* kd = (bf16*)(ws + (tile == 3 ? WS_KS : WS_KW)) + ((size_t)h * RP + r) * 64 + 8 * fq;
                                *(v4u*)kd = pack8u(o10, o11); *(v4u*)(kd + 32) = pack8u(o20, o21); }
                            else { bf16* vd = (bf16*)(ws + (tile == 3 ? WS_VST : WS_VWT)) + ((size_t)(h * 64 + 8 * fq)) * RP + r;
#pragma unroll
                                for (int j = 0; j < 4; ++j) { vd[(size_t)j * RP] = bf1(o10[j]); vd[(size_t)(4 + j) * RP] = bf1(o11[j]);
                                    vd[(size_t)(32 + j) * RP] = bf1(o20[j]); vd[(size_t)(36 + j) * RP] = bf1(o21[j]); } }
                        }
                    }
                } else if (tile < 9) {
                    const bool isk = tile >= 7; const int head = 2 * ((tile - 5) & 1) + (wc >> 1), dd0 = 32 * (wc & 1) + 8 * fq;
                    const float* cp = (const float*)(ws + WS_COS128) + (size_t)pos * 64 + dd0; const float* sp = (const float*)(ws + WS_SIN128) + (size_t)pos * 64 + dd0;
                    const f4 c0 = *(const f4*)cp, c1 = *(const f4*)(cp + 4), s0 = *(const f4*)sp, s1 = *(const f4*)(sp + 4);
                    float scl = isk ? RK_SCALE : 1.0f;
                    if (is_p) scl *= ((const float*)(ws + (isk ? WS_GINV : WS_GPOW)))[head * 132 + (r & 127) + 1];
                    const f4 o10 = (a0 * c0 - b0 * s0) * scl, o11 = (a1 * c1 - b1 * s1) * scl, o20 = (a0 * s0 + b0 * c0) * scl, o21 = (a1 * s1 + b1 * c1) * scl;
                    bf16* nd = (bf16*)(ws + (isk ? WS_RKI : WS_RQD)) + ((size_t)r * 4 + head) * 128 + dd0;
                    *(v4u*)nd = pack8u(o10, o11); *(v4u*)(nd + 64) = pack8u(o20, o21);
                    if (isk) { bf16* td = (bf16*)(ws + WS_RKIT) + ((size_t)(head * 128 + dd0)) * RP + r;
#pragma unroll
                        for (int j = 0; j < 4; ++j) { td[(size_t)j * RP] = bf1(o10[j]); td[(size_t)(4 + j) * RP] = bf1(o11[j]);
                            td[(size_t)(64 + j) * RP] = bf1(o20[j]); td[(size_t)(68 + j) * RP] = bf1(o21[j]); } }
                } else if (tile < 13) {
                    bf16* td = (bf16*)(ws + WS_RVT) + ((size_t)((tile - 9) * 256 + 32 * wc + 8 * fq)) * RP + r;
#pragma unroll
                    for (int j = 0; j < 4; ++j) { td[(size_t)j * RP] = bf1(a0[j]); td[(size_t)(4 + j) * RP] = bf1(a1[j]);
                        td[(size_t)(128 + j) * RP] = bf1(b0[j]); td[(size_t)(132 + j) * RP] = bf1(b1[j]); }
                } else if (tile < 25) {
                    const int t4 = (tile - 13) >> 2; bf16* dst = (bf16*)(ws + (t4 == 0 ? WS_SRG : (t4 == 1 ? WS_SGA : WS_SGB))) + (size_t)r * 1024 + 256 * ((tile - 13) & 3) + 32 * wc + 8 * fq;
                    f4 x0, x1, y0, y1;
#pragma unroll
                    for (int j = 0; j < 4; ++j) { const float g0 = sigmoidf_(a0[j]), g1 = sigmoidf_(a1[j]), g2 = sigmoidf_(b0[j]), g3 = sigmoidf_(b1[j]);
                        x0[j] = t4 == 0 ? a0[j] * g0 : g0; x1[j] = t4 == 0 ? a1[j] * g1 : g1; y0[j] = t4 == 0 ? b0[j] * g2 : g2; y1[j] = t4 == 0 ? b1[j] * g3 : g3; }
                    *(v4u*)dst = pack8u(x0, x1); *(v4u*)(dst + 128) = pack8u(y0, y1);
                } else {
                    if (wc == 0 && fq < 3) { float* gd = (float*)(ws + WS_GN) + (size_t)r * 24 + 8 * fq; f4 x0, x1;
#pragma unroll
                        for (int j = 0; j < 4; ++j) { x0[j] = sigmoidf_(a0[j]); x1[j] = sigmoidf_(a1[j]); }
                        *(f4*)gd = x0; *(f4*)(gd + 4) = x1; }
                }
            }
    }
};
__device__ __forceinline__ void bf8_to_f(const v4u w, f4& a, f4& b) {
    a[0] = __builtin_bit_cast(float, w.x << 16); a[1] = __builtin_bit_cast(float, w.x & 0xffff0000u); a[2] = __builtin_bit_cast(float, w.y << 16); a[3] = __builtin_bit_cast(float, w.y & 0xffff0000u);
    b[0] = __builtin_bit_cast(float, w.z << 16); b[1] = __builtin_bit_cast(float, w.z & 0xffff0000u); b[2] = __builtin_bit_cast(float, w.w << 16); b[3] = __builtin_bit_cast(float, w.w & 0xffff0000u);
}
struct EpiMixA {
    static constexpr bool PERM = true, AFTER_DRAIN = false;
    unsigned char* ws;
    __device__ __forceinline__ void operator()(const f4 (&acc)[2][2][4][2], const pg8::Unit& u, int wr, int wc, int fr, int fq) const { run<2, 4>(acc, u, wr, wc, fr, fq); }
    template <int NAI, int NM> __device__ __forceinline__ void run(const f4 (&acc)[2][2][4][2], const pg8::Unit& u, int wr, int wc, int fr, int fq) const {
        const size_t o0 = (size_t)(u.pm * 256 + wr * 64 + fr) * 1024 + u.pn * 256 + 32 * wc + 8 * fq;
        v4u gt[NAI][NM][2];
#pragma unroll
        for (int ai = 0; ai < NAI; ++ai)
#pragma unroll
            for (int m = 0; m < NM; ++m)
#pragma unroll
                for (int bj = 0; bj < 2; ++bj) gt[ai][m][bj] = *(const v4u*)((const bf16*)(ws + WS_SGA) + o0 + (size_t)(ai * 128 + m * 16) * 1024 + 128 * bj);
#pragma unroll
        for (int ai = 0; ai < NAI; ++ai)
#pragma unroll
            for (int m = 0; m < NM; ++m)
#pragma unroll
                for (int bj = 0; bj < 2; ++bj) { f4 g0, g1; bf8_to_f(gt[ai][m][bj], g0, g1);
                    *(v4u*)((bf16*)(ws + WS_MIXA) + o0 + (size_t)(ai * 128 + m * 16) * 1024 + 128 * bj) = pack8u(acc[ai][bj][m][0] * g0, acc[ai][bj][m][1] * g1); }
    }
};
struct EpiMixed {
    static constexpr bool PERM = true, AFTER_DRAIN = false;
    unsigned char* ws;
    __device__ __forceinline__ void operator()(const f4 (&acc)[2][2][4][2], const pg8::Unit& u, int wr, int wc, int fr, int fq) const { run<2, 4>(acc, u, wr, wc, fr, fq); }
    template <int NAI, int NM> __device__ __forceinline__ void run(const f4 (&acc)[2][2][4][2], const pg8::Unit& u, int wr, int wc, int fr, int fq) const {
        const size_t o0 = (size_t)(u.pm * 256 + wr * 64 + fr) * 1024 + u.pn * 256 + 32 * wc + 8 * fq;
#pragma unroll
        for (int ai = 0; ai < NAI; ++ai) {
            v4u gt[NM][2], mt[NM][2];
#pragma unroll
            for (int m = 0; m < NM; ++m)
#pragma unroll
                for (int bj = 0; bj < 2; ++bj) { const size_t o = o0 + (size_t)(ai * 128 + m * 16) * 1024 + 128 * bj;
                    gt[m][bj] = *(const v4u*)((const bf16*)(ws + WS_SGB) + o); mt[m][bj] = *(const v4u*)((const bf16*)(ws + WS_MIXA) + o); }
#pragma unroll
            for (int m = 0; m < NM; ++m)
#pragma unroll
                for (int bj = 0; bj < 2; ++bj) { const size_t o = o0 + (size_t)(ai * 128 + m * 16) * 1024 + 128 * bj;
                    f4 g0, g1, m0, m1; bf8_to_f(gt[m][bj], g0, g1); bf8_to_f(mt[m][bj], m0, m1);
                    *(v4u*)((bf16*)(ws + WS_MIXED) + o) = pack8u(m0 + acc[ai][bj][m][0] * g0, m1 + acc[ai][bj][m][1] * g1); }
        }
    }
};
struct EpiResid {
    static constexpr bool PERM = true, AFTER_DRAIN = false;
    unsigned char* ws; const float* xp; const float* xs; int gate_off; bool first;
    __device__ __forceinline__ void operator()(const f4 (&acc)[2][2][4][2], const pg8::Unit& u, int wr, int wc, int fr, int fq) const { run<2, 4>(acc, u, wr, wc, fr, fq); }
    __device__ __forceinline__ void run_main(const f4 (&acc)[2][2][4][2], const pg8::Unit& u, int wr, int wc, int fr, int fq) const {
        const int r0 = u.pm * 256 + wr * 64 + fr, c0 = u.pn * 256 + 32 * wc + 8 * fq;
        f4 gz[2][2];
#pragma unroll
        for (int bj = 0; bj < 2; ++bj) { const float* gate = (const float*)(ws + WS_MOD) + gate_off + c0 + 128 * bj; gz[bj][0] = *(const f4*)gate; gz[bj][1] = *(const f4*)(gate + 4); }
        const float* basep = first ? xp : (const float*)(ws + WS_X1);
        float* outp = (float*)(ws + (first ? WS_X1 : WS_X2));
#pragma unroll
        for (int ai = 0; ai < 2; ++ai) {
            f4 bv[4][2][2];
#pragma unroll
            for (int m = 0; m < 4; ++m)
#pragma unroll
                for (int bj = 0; bj < 2; ++bj) { const float* bp = basep + (size_t)(r0 + 128 * ai + 16 * m) * 1024 + c0 + 128 * bj;
                    bv[m][bj][0] = __builtin_nontemporal_load((const f4*)bp); bv[m][bj][1] = __builtin_nontemporal_load((const f4*)(bp + 4)); }
#pragma unroll
            for (int m = 0; m < 4; ++m)
#pragma unroll
                for (int bj = 0; bj < 2; ++bj) { float* xo = outp + (size_t)(r0 + 128 * ai + 16 * m) * 1024 + c0 + 128 * bj;
                    *(f4*)xo = bv[m][bj][0] + gz[bj][0] * acc[ai][bj][m][0]; *(f4*)(xo + 4) = bv[m][bj][1] + gz[bj][1] * acc[ai][bj][m][1]; }
        }
    }
    template <int NAI, int NM> __device__ __forceinline__ void run(const f4 (&acc)[2][2][4][2], const pg8::Unit& u, int wr, int wc, int fr, int fq) const {
        if constexpr (NAI == 2 && NM == 4) { run_main(acc, u, wr, wc, fr, fq); return; }
#pragma unroll
        for (int ai = 0; ai < NAI; ++ai)
#pragma unroll
            for (int m = 0; m < NM; ++m) { const int r = u.pm * 256 + ai * 128 + wr * 64 + m * 16 + fr;
                const int b = r - T; const int modrow = r < T ? 0 : (b < NBATCH ? b + 1 : 0);
                const float* gate = (const float*)(ws + WS_MOD) + (size_t)modrow * 6144 + gate_off;
                float* x1 = (float*)(ws + (first ? WS_X1 : WS_X2)) + (size_t)r * 1024;
                const float* base = first ? (r < T ? xp + (size_t)r * 1024 : (b < NBATCH ? xs + (size_t)b * 1024 : nullptr)) : (const float*)(ws + WS_X1) + (size_t)r * 1024;
#pragma unroll
                for (int bj = 0; bj < 2; ++bj) { const int c = u.pn * 256 + 128 * bj + 32 * wc + 8 * fq;
                    f4 v0 = {0.f, 0.f, 0.f, 0.f}, v1 = v0; if (base) { v0 = __builtin_nontemporal_load((const f4*)(base + c)); v1 = __builtin_nontemporal_load((const f4*)(base + c + 4)); }
                    v0 += *(const f4*)(gate + c) * acc[ai][bj][m][0]; v1 += *(const f4*)(gate + c + 4) * acc[ai][bj][m][1];
                    *(f4*)(x1 + c) = v0; *(f4*)(x1 + c + 4) = v1; } }
    }
};
struct EpiUp {
    static constexpr bool PERM = true, AFTER_DRAIN = false;
    unsigned char* ws;
    __device__ __forceinline__ void operator()(const f4 (&acc)[2][2][4][2], const pg8::Unit& u, int wr, int wc, int fr, int fq) const { run<2, 4>(acc, u, wr, wc, fr, fq); }
    template <int NAI, int NM> __device__ __forceinline__ void run(const f4 (&acc)[2][2][4][2], const pg8::Unit& u, int wr, int wc, int fr, int fq) const {
#pragma unroll
        for (int ai = 0; ai < NAI; ++ai)
#pragma unroll
            for (int m = 0; m < NM; ++m) { const size_t r = (size_t)(u.pm * 256 + ai * 128 + wr * 64 + m * 16 + fr);
#pragma unroll
                for (int bj = 0; bj < 2; ++bj) { const size_t o = r * 4096 + u.pn * 256 + 128 * bj + 32 * wc + 8 * fq;
                    f4 v0 = acc[ai][bj][m][0], v1 = acc[ai][bj][m][1];
#pragma unroll
                    for (int j = 0; j < 4; ++j) { const float p = fmaxf(v0[j], 0.f), q = fmaxf(v1[j], 0.f); v0[j] = p * p; v1[j] = q * q; }
                    *(v4u*)((bf16*)(ws + WS_UP) + o) = pack8u(v0, v1); } }
    }
};

template <class Epi>
__device__ __forceinline__ void skinny_subunit(Ctx& C, const bf16* A, const bf16* Bt, int K, int pn, int wcs, const Epi& E) {
    const int lane = C.lane, r = lane & 15, fq = lane >> 4, w = C.wave;
    const int kw = K >> 3;
    f4 acc[2][2][2];
#pragma unroll
    for (int i = 0; i < 8; ++i) acc[i >> 2][(i >> 1) & 1][i & 1] = (f4){0.f, 0.f, 0.f, 0.f};
    const bf16* ap = A + (size_t)(T + r) * K + w * kw + 8 * fq;
    const bf16* bp = Bt + (size_t)(256 * pn + 32 * wcs + 8 * (r >> 2) + (r & 3)) * K + w * kw + 8 * fq;
#pragma unroll 2
    for (int ks = 0; ks < kw; ks += 32) {
        bf16x8 af[2], wf[2][2];
#pragma unroll
        for (int m = 0; m < 2; ++m) af[m] = *(const bf16x8*)(ap + (size_t)(16 * m) * K + ks);
#pragma unroll
        for (int bj = 0; bj < 2; ++bj)
#pragma unroll
            for (int n = 0; n < 2; ++n) wf[bj][n] = *(const bf16x8*)(bp + (size_t)(128 * bj + 4 * n) * K + ks);
#pragma unroll
        for (int bj = 0; bj < 2; ++bj)
#pragma unroll
            for (int m = 0; m < 2; ++m)
#pragma unroll
                for (int n = 0; n < 2; ++n) acc[bj][m][n] = MFMA16(wf[bj][n], af[m], acc[bj][m][n]);
    }
    LAS f4* red = (LAS f4*)C.lds;
#pragma unroll
    for (int i = 0; i < 8; ++i) red[(w * 8 + i) * 64 + lane] = acc[i >> 2][(i >> 1) & 1][i & 1];
    __syncthreads();
    { f4 sacc = red[w * 64 + lane];
#pragma unroll
      for (int ww = 1; ww < 8; ++ww) sacc += red[(ww * 8 + w) * 64 + lane];
      red[(64 + w) * 64 + lane] = sacc; }
    __syncthreads();
    if (w == 0) {
        f4 full[2][2][4][2];
#pragma unroll
        for (int i = 0; i < 8; ++i) full[0][i >> 2][(i >> 1) & 1][i & 1] = red[(64 + i) * 64 + lane];
        E.template run<1, 2>(full, pg8::Unit{64, pn}, 0, wcs, r, fq);
    }
    __syncthreads();
}
template <class Epi>
__device__ __forceinline__ void skinny_phase(Ctx& C, const bf16* A, const bf16* Bt, int N, int K, const Epi& E) {
    const int nsub = (N >> 8) * 4, off = (64 * (N >> 8)) % C.nb;
    A = launder_p(A); Bt = launder_p(Bt); C.tid = launder_v(C.tid); C.lane = C.tid & 63;
    int su = C.bid - off; if (su < 0) su += C.nb;
#pragma unroll 1
    for (; su < nsub; su += C.nb) skinny_subunit(C, A, Bt, K, su >> 2, su & 3, E);
}

struct AttnAcc { float m, l; f4 o[4]; };
__device__ __forceinline__ void attn_init(AttnAcc& a) { a.m = -1e30f; a.l = 0.f;
#pragma unroll
    for (int c = 0; c < 4; ++c) a.o[c] = (f4){0.f, 0.f, 0.f, 0.f}; }
struct SrcB { const bf16* K; const bf16* VT; int pitch; };
struct SrcF { const float* base; int koff, voff, nrows; };
__device__ __forceinline__ void load_k(const SrcB& s, int kb, int lane, bf16x8 (&kf)[2][2]) {
    const int r = lane & 15, fq = lane >> 4;
#pragma unroll
    for (int kt = 0; kt < 2; ++kt) { const bf16* p = s.K + (size_t)(kb + 8 * (r >> 2) + 4 * kt + (r & 3)) * 64 + 8 * fq; kf[kt][0] = *(const bf16x8*)p; kf[kt][1] = *(const bf16x8*)(p + 32); }
}
__device__ __forceinline__ void load_v(const SrcB& s, int kb, int lane, bf16x8 (&vf)[4]) {
    const int r = lane & 15, fq = lane >> 4;
#pragma unroll
    for (int c = 0; c < 4; ++c) vf[c] = *(const bf16x8*)(s.VT + (size_t)(16 * c + r) * s.pitch + kb + 8 * fq);
}
__device__ __forceinline__ void load_k(const SrcF& s, int kb, int lane, bf16x8 (&kf)[2][2]) {
    const int r = lane & 15, fq = lane >> 4;
#pragma unroll
    for (int kt = 0; kt < 2; ++kt) { int key = kb + 8 * (r >> 2) + 4 * kt + (r & 3); key = key < s.nrows ? key : s.nrows - 1;
        const float* p = s.base + (size_t)key * 256 + s.koff + 8 * fq;
        kf[kt][0] = pack8(*(const f4*)p, *(const f4*)(p + 4)); kf[kt][1] = pack8(*(const f4*)(p + 32), *(const f4*)(p + 36)); }
}
__device__ __forceinline__ void load_v(const SrcF& s, int kb, int lane, bf16x8 (&vf)[4]) {
    const int r = lane & 15, fq = lane >> 4;
#pragma unroll
    for (int c = 0; c < 4; ++c) { f4 x, y;
#pragma unroll
        for (int j = 0; j < 4; ++j) { int k0 = kb + 8 * fq + j, k1 = k0 + 4; k0 = k0 < s.nrows ? k0 : s.nrows - 1; k1 = k1 < s.nrows ? k1 : s.nrows - 1;
            x[j] = s.base[(size_t)k0 * 256 + s.voff + 16 * c + r]; y[j] = s.base[(size_t)k1 * 256 + s.voff + 16 * c + r]; }
        vf[c] = pack8(x, y); }
}
__device__ __forceinline__ void qk_scores(const bf16x8 (&kf)[2][2], const bf16x8 (&bq)[2], f4& s0, f4& s1) {
    s0 = (f4){0.f, 0.f, 0.f, 0.f}; s1 = s0;
    s0 = MFMA16(kf[0][0], bq[0], s0); s0 = MFMA16(kf[0][1], bq[1], s0);
    s1 = MFMA16(kf[1][0], bq[0], s1); s1 = MFMA16(kf[1][1], bq[1], s1);
}
constexpr float MAX_SLACK = 8.0f;
template <class Mask>
__device__ __forceinline__ void attn_chunk(AttnAcc& a, const bf16x8 (&kf)[2][2], const bf16x8 (&vf)[4], const bf16x8 (&bq)[2], int kb, int fq, const Mask& mask) {
    f4 s0, s1; qk_scores(kf, bq, s0, s1);
    bool v0[4], v1[4]; float mx = -1e30f;
#pragma unroll
    for (int j = 0; j < 4; ++j) { v0[j] = mask(kb + 8 * fq + j); v1[j] = mask(kb + 8 * fq + 4 + j); mx = fmaxf(mx, v0[j] ? s0[j] : -1e30f); mx = fmaxf(mx, v1[j] ? s1[j] : -1e30f); }
    if (__any(mx > a.m + MAX_SLACK)) {
        mx = fmaxf(mx, __shfl_xor(mx, 16)); mx = fmaxf(mx, __shfl_xor(mx, 32));
        const float mn = fmaxf(a.m, mx), alpha = fexp2(a.m - mn); a.m = mn; a.l *= alpha;
#pragma unroll
        for (int c = 0; c < 4; ++c) a.o[c] = a.o[c] * alpha;
    }
    f4 p0, p1; float ps = 0.f;
#pragma unroll
    for (int j = 0; j < 4; ++j) { p0[j] = v0[j] ? fexp2(s0[j] - a.m) : 0.f; p1[j] = v1[j] ? fexp2(s1[j] - a.m) : 0.f; ps += p0[j] + p1[j]; }
    a.l += ps;
    const bf16x8 pb = pack8(p0, p1);
#pragma unroll
    for (int c = 0; c < 4; ++c) a.o[c] = MFMA16(vf[c], pb, a.o[c]);
}
__device__ __forceinline__ void attn_tile64_full(AttnAcc& a, const bf16x8 (&kf)[2][2][2], const bf16x8 (&vf)[2][4], const bf16x8 (&bq)[2], float colbias = 0.f) {
    f4 s[2][2];
#pragma unroll
    for (int ch = 0; ch < 2; ++ch)
#pragma unroll
        for (int kt = 0; kt < 2; ++kt) { f4 t = (f4){colbias, colbias, colbias, colbias}; t = MFMA16(kf[ch][kt][0], bq[0], t); s[ch][kt] = MFMA16(kf[ch][kt][1], bq[1], t); }
    float mx = -1e30f;
#pragma unroll
    for (int ch = 0; ch < 2; ++ch)
#pragma unroll
        for (int h = 0; h < 2; ++h) mx = fmaxf(mx, fmaxf(fmaxf(s[ch][h][0], s[ch][h][1]), fmaxf(s[ch][h][2], s[ch][h][3])));
    if (__any(mx > a.m + MAX_SLACK)) {
        mx = fmaxf(mx, __shfl_xor(mx, 16)); mx = fmaxf(mx, __shfl_xor(mx, 32));
        const float mn = fmaxf(a.m, mx), alpha = fexp2(a.m - mn); a.m = mn; a.l *= alpha;
#pragma unroll
        for (int c = 0; c < 4; ++c) a.o[c] = a.o[c] * alpha;
    }
    float ps = 0.f; bf16x8 pb[2];
#pragma unroll
    for (int ch = 0; ch < 2; ++ch) { f4 p0, p1;
#pragma unroll
        for (int j = 0; j < 4; ++j) { p0[j] = fexp2(s[ch][0][j] - a.m); p1[j] = fexp2(s[ch][1][j] - a.m); ps += p0[j] + p1[j]; }
        pb[ch] = pack8(p0, p1); }
    a.l += ps;
#pragma unroll
    for (int ch = 0; ch < 2; ++ch)
#pragma unroll
        for (int c = 0; c < 4; ++c) a.o[c] = MFMA16(vf[ch][c], pb[ch], a.o[c]);
}
template <class Mask>
__device__ __forceinline__ void attn_tile64(AttnAcc& a, const bf16x8 (&kf)[2][2][2], const bf16x8 (&vf)[2][4], const bf16x8 (&bq)[2], int kb, int fq, const Mask& mask) {
    f4 s[2][2];
#pragma unroll
    for (int ch = 0; ch < 2; ++ch) qk_scores(kf[ch], bq, s[ch][0], s[ch][1]);
    bool v[2][2][4]; float mx = -1e30f;
#pragma unroll
    for (int ch = 0; ch < 2; ++ch)
#pragma unroll
        for (int h = 0; h < 2; ++h)
#pragma unroll
            for (int j = 0; j < 4; ++j) { v[ch][h][j] = mask(kb + 32 * ch + 8 * fq + 4 * h + j); mx = fmaxf(mx, v[ch][h][j] ? s[ch][h][j] : -1e30f); }
    if (__any(mx > a.m + MAX_SLACK)) {
        mx = fmaxf(mx, __shfl_xor(mx, 16)); mx = fmaxf(mx, __shfl_xor(mx, 32));
        const float mn = fmaxf(a.m, mx), alpha = fexp2(a.m - mn); a.m = mn; a.l *= alpha;
#pragma unroll
        for (int c = 0; c < 4; ++c) a.o[c] = a.o[c] * alpha;
    }
    float ps = 0.f; bf16x8 pb[2];
#pragma unroll
    for (int ch = 0; ch < 2; ++ch) { f4 p0, p1;
#pragma unroll
        for (int j = 0; j < 4; ++j) { p0[j] = v[ch][0][j] ? fexp2(s[ch][0][j] - a.m) : 0.f; p1[j] = v[ch][1][j] ? fexp2(s[ch][1][j] - a.m) : 0.f; ps += p0[j] + p1[j]; }
        pb[ch] = pack8(p0, p1); }
    a.l += ps;
#pragma unroll
    for (int ch = 0; ch < 2; ++ch)
#pragma unroll
        for (int c = 0; c < 4; ++c) a.o[c] = MFMA16(vf[ch][c], pb[ch], a.o[c]);
}
__device__ __forceinline__ void select_blocks(const LAS float* sc, LAS unsigned* selm, int jhi, int f1, int f2, int lane) {
    unsigned key[4]; bool cand[4];
#pragma unroll
    for (int rr = 0; rr < 4; ++rr) { const int j = 4 * lane + rr; cand[rr] = (j >= 1) && (j <= jhi); key[rr] = cand[rr] ? __builtin_bit_cast(unsigned, sc[j]) : 0u; }
    unsigned prefix = 0u;
#pragma unroll 1
    for (int bit = 30; bit >= 0; --bit) {
        const unsigned c = prefix | (1u << bit); int cnt = 0;
#pragma unroll
        for (int rr = 0; rr < 4; ++rr) cnt += __popcll(__ballot(cand[rr] && key[rr] >= c));
        if (cnt >= 13) prefix = c;
    }
    int cgt = 0; unsigned long long be[4];
#pragma unroll
    for (int rr = 0; rr < 4; ++rr) { cgt += __popcll(__ballot(cand[rr] && key[rr] > prefix)); be[rr] = __ballot(cand[rr] && key[rr] == prefix); }
    const int need = 13 - cgt; const unsigned long long lt = (1ull << lane) - 1ull;
    int before = 0;
#pragma unroll
    for (int rr = 0; rr < 4; ++rr) before += __popcll(be[rr] & lt);
    unsigned nib = 0u;
#pragma unroll
    for (int rr = 0; rr < 4; ++rr) { const int j = 4 * lane + rr; const bool eq = cand[rr] && key[rr] == prefix;
        const bool sel = (cand[rr] && key[rr] > prefix) || (eq && before < need) || (j == 0) || (j == f1) || (j == f2);
        before += eq ? 1 : 0; nib |= sel ? (1u << rr) : 0u; }
    if (lane < 8) selm[lane] = 0u;
    WAVE_SYNC();
    __hip_atomic_fetch_or(selm + (lane >> 3), nib << (4 * (lane & 7)), __ATOMIC_RELAXED, __HIP_MEMORY_SCOPE_WORKGROUP);
    WAVE_SYNC();
}
template <class Src, class Mask>
__device__ __forceinline__ void attn_range(AttnAcc& a, const Src& src, const bf16x8 (&bq)[2], int kb0, int kb1, int lane, const Mask& mask) {
    if (kb0 >= kb1) return;
    bf16x8 kf[2][2], vf[4]; load_k(src, kb0, lane, kf); load_v(src, kb0, lane, vf);
    for (int kb = kb0; kb < kb1; kb += 32) {
        bf16x8 kn[2][2], vn[4]; const int kbn = (kb + 32 < kb1) ? kb + 32 : kb;
        load_k(src, kbn, lane, kn); load_v(src, kbn, lane, vn);
        attn_chunk(a, kf, vf, bq, kb, lane >> 4, mask);
#pragma unroll
        for (int i = 0; i < 2; ++i) { kf[i][0] = kn[i][0]; kf[i][1] = kn[i][1]; }
#pragma unroll
        for (int c = 0; c < 4; ++c) vf[c] = vn[c];
    }
}
__device__ __forceinline__ float col_total(float l) { l += __shfl_xor(l, 16); l += __shfl_xor(l, 32); return l; }

template <bool SAMPLE>
__device__ __forceinline__ void nsa_task(Ctx& C, int task) {
    const int lane = C.lane, r = lane & 15, fq = lane >> 4, qi = r >> 2, g = r & 3;
    LAS float* SC = (LAS float*)(C.lds + C.wave * 16384);
    LAS unsigned* SELM = (LAS unsigned*)(C.lds + C.wave * 16384 + 4096);
    const int kvh = task & 1, b = task >> 1, t0 = SAMPLE ? T : 4 * (task >> 1);
    const int tl = SAMPLE ? T : t0 + qi;
    const int rowq = SAMPLE ? T + b : tl;
    const int head = kvh * 4 + g;
    bf16x8 bq[2];
    { const bf16* qp = WSP(bf16, WS_Q) + ((size_t)rowq * 8 + head) * 64 + 8 * fq; bq[0] = *(const bf16x8*)qp; bq[1] = *(const bf16x8*)(qp + 32); }
    const float* gn = WSP(float, WS_GN) + (size_t)rowq * 24 + head * 3;
    const float g_c = gn[0], g_s = gn[1], g_w = gn[2];
    f4 outv[4];
    {
        const SrcB src = SAMPLE ? SrcB{WSP(bf16, WS_CMPKS) + (size_t)(b * 2 + kvh) * 65536, WSP(bf16, WS_CMPVS) + (size_t)(b * 2 + kvh) * 65536, 1024}
                                : SrcB{WSP(bf16, WS_CMPKP) + (size_t)kvh * 65536, WSP(bf16, WS_CMPVP) + (size_t)kvh * 65536, 1024};
        const int nvis = tl >= 31 ? ((tl - 31) >> 4) + 1 : 0;
        const int tmax = SAMPLE ? T : t0 + 3; const int nvmax = tmax >= 31 ? ((tmax - 31) >> 4) + 1 : 0;
        const int kend = ((nvmax + 31) >> 5) << 5;
        float m = -1e30f, l = 0.f;
        for (int kb = 0; kb < kend; kb += 32) {
            bf16x8 kf[2][2]; load_k(src, kb, lane, kf);
            f4 s0, s1; qk_scores(kf, bq, s0, s1);
            float mx = -1e30f;
#pragma unroll
            for (int j = 0; j < 4; ++j) { mx = fmaxf(mx, (kb + 8 * fq + j < nvis) ? s0[j] : -1e30f); mx = fmaxf(mx, (kb + 8 * fq + 4 + j < nvis) ? s1[j] : -1e30f); }
            if (__any(mx > m + MAX_SLACK)) { mx = fmaxf(mx, __shfl_xor(mx, 16)); mx = fmaxf(mx, __shfl_xor(mx, 32));
                const float mn = fmaxf(m, mx); l *= fexp2(m - mn); m = mn; }
            float ps = 0.f;
#pragma unroll
            for (int j = 0; j < 4; ++j) { ps += (kb + 8 * fq + j < nvis) ? fexp2(s0[j] - m) : 0.f; ps += (kb + 8 * fq + 4 + j < nvis) ? fexp2(s1[j] - m) : 0.f; }
            l += ps;
        }
        l = col_total(l); const float il = l > 0.f ? 1.0f / l : 0.f;
#pragma unroll
        for (int i = 0; i < 16; ++i) SC[lane * 16 + i] = 0.f;
        WAVE_SYNC();
        f4 o[4];
#pragma unroll
        for (int c = 0; c < 4; ++c) o[c] = (f4){0.f, 0.f, 0.f, 0.f};
        float tprev = 0.f;
        for (int kb = 0; kb < kend; kb += 32) {
            bf16x8 kf[2][2], vf[4]; load_k(src, kb, lane, kf); load_v(src, kb, lane, vf);
            f4 s0, s1; qk_scores(kf, bq, s0, s1);
            f4 p0, p1;
#pragma unroll
            for (int j = 0; j < 4; ++j) { p0[j] = (kb + 8 * fq + j < nvis) ? fexp2(s0[j] - m) * il : 0.f; p1[j] = (kb + 8 * fq + 4 + j < nvis) ? fexp2(s1[j] - m) * il : 0.f; }
            const bf16x8 pb = pack8(p0, p1);
#pragma unroll
            for (int c = 0; c < 4; ++c) o[c] = MFMA16(vf[c], pb, o[c]);
            const float tcur = p1[3];
            const float up_same = __shfl(tcur, (lane + 48) & 63), up_prev = __shfl(tprev, (lane + 48) & 63);
            tprev = tcur;
            float g0 = (p0[0] + p0[1]) + (p0[2] + p0[3]) + (fq ? up_same : up_prev);
            float g1 = (p1[0] + p1[1]) + (p1[2] + p1[3]) + p0[3];
            g0 += __shfl_xor(g0, 1); g0 += __shfl_xor(g0, 2); g1 += __shfl_xor(g1, 1); g1 += __shfl_xor(g1, 2);
            { const int jb = (kb >> 2) + 2 * fq; SC[qi * 256 + jb] = g0; SC[qi * 256 + jb + 1] = g1; }
        }
#pragma unroll
        for (int c = 0; c < 4; ++c) outv[c] = o[c] * g_c;
    }
    WAVE_SYNC();
    {
        constexpr int NQ = SAMPLE ? 1 : 4;
#pragma unroll 1
        for (int q = 0; q < NQ; ++q) {
            const int tq = SAMPLE ? T : t0 + q; const int qblk = tq >> 6;
            if (!SAMPLE && qblk < 16) { if (lane < 8) SELM[q * 8 + lane] = (lane == 0) ? ((1u << (qblk + 1)) - 1u) : 0u; }
            else select_blocks(SC + q * 256, SELM + q * 8, SAMPLE ? 254 : qblk - 2, SAMPLE ? 255 : qblk, SAMPLE ? 255 : qblk - 1, lane);
        }
    }
    WAVE_SYNC();
    {
        AttnAcc a; attn_init(a);
        const int qsel = SAMPLE ? 0 : qi;
#pragma unroll
        for (int w = 0; w < 8; ++w) {
            const unsigned mw = SELM[qsel * 8 + w];
            unsigned uw = SAMPLE ? SELM[w] : (SELM[w] | SELM[8 + w] | SELM[16 + w] | SELM[24 + w]);
            uw = (unsigned)__builtin_amdgcn_readfirstlane((int)uw);
            while (uw) {
                const int bit = __builtin_ctz(uw); uw &= uw - 1u; const int blk = 32 * w + bit;
                const bool mysel = (mw >> bit) & 1u;
                if (SAMPLE) {
                    const int phys = ((const int*)C.in[8])[b * 128 + (blk >> 1)];
                    const SrcF src{C.in[5] + ((size_t)phys * 128 + (size_t)(blk & 1) * 64) * 256, kvh * 64, 128 + kvh * 64, 64};
                    attn_range(a, src, bq, 0, 64, lane, [&](int) { return mysel; });
                } else {
                    const SrcB src{WSP(bf16, WS_KS) + (size_t)kvh * RP * 64, WSP(bf16, WS_VST) + (size_t)kvh * 64 * RP, RP};
                    attn_range(a, src, bq, 64 * blk, 64 * blk + 64, lane, [&](int key) { return mysel && key <= tl; });
                }
            }
        }
        if (SAMPLE) {
            const SrcF src{C.out + O_SELS + (size_t)b * 256, kvh * 64, 128 + kvh * 64, 1};
            attn_range(a, src, bq, 0, 32, lane, [&](int key) { return key == 0; });
        }
        const float l = col_total(a.l); const float sc = l > 0.f ? g_s / l : 0.f;
#pragma unroll
        for (int c = 0; c < 4; ++c) outv[c] += a.o[c] * sc;
    }
    {
        AttnAcc a; attn_init(a);
        if (SAMPLE) {
            const SrcF src{C.out + O_WINS + (size_t)b * 512 * 256, kvh * 64, 128 + kvh * 64, 512};
            attn_range(a, src, bq, 0, 512, lane, [&](int) { return true; });
        } else {
            const SrcB src{WSP(bf16, WS_KW) + (size_t)kvh * RP * 64, WSP(bf16, WS_VWT) + (size_t)kvh * 64 * RP, RP};
            int k0 = t0 - 511; k0 = k0 < 0 ? 0 : k0; k0 &= ~31;
            attn_range(a, src, bq, k0, t0 + 4, lane, [&](int key) { return key <= tl && key > tl - 512; });
        }
        const float l = col_total(a.l); const float sc = l > 0.f ? g_w / l : 0.f;
#pragma unroll
        for (int c = 0; c < 4; ++c) outv[c] += a.o[c] * sc;
    }
    if (!SAMPLE || qi == 0) {
        bf16* od = WSP(bf16, WS_ONSA) + (size_t)rowq * 512 + head * 64 + 4 * fq;
#pragma unroll
        for (int c = 0; c < 4; ++c) { v2u w; w.x = cvtpk(outv[c][0], outv[c][1]); w.y = cvtpk(outv[c][2], outv[c][3]); *(v2u*)(od + 16 * c) = w; }
    }
    WAVE_SYNC();
}

__device__ __forceinline__ void merge_parts(const LAS float* PART, int lane, int slot, float gate, f4 (&outv)[4], float xm, float xl, const f4 (&xo)[4]) {
    float M = xm;
#pragma unroll
    for (int w = 0; w < 8; ++w) M = fmaxf(M, PART[(w * 64 + lane) * 40 + slot]);
    const float xs = fexp2(xm - M);
    float L = xl * xs; f4 o[4];
#pragma unroll
    for (int c = 0; c < 4; ++c) o[c] = xo[c] * xs;
#pragma unroll
    for (int w = 0; w < 8; ++w) { const LAS float* p = PART + (w * 64 + lane) * 40 + slot; const float sc = fexp2(p[0] - M); L += p[1] * sc;
#pragma unroll
        for (int c = 0; c < 4; ++c) o[c] += *(const LAS f4*)(p + 4 + 4 * c) * sc; }
    L = col_total(L); const float s = L > 0.f ? gate / L : 0.f;
#pragma unroll
    for (int c = 0; c < 4; ++c) outv[c] += o[c] * s;
}
__device__ __forceinline__ void nsa_sample_block(Ctx& C, int task) {
    const int lane = C.lane, r = lane & 15, fq = lane >> 4, g = r & 3, w = C.wave;
    const int kvh = task & 1, b = task >> 1, rowq = T + b, head = kvh * 4 + g;
    LAS float* SCs = (LAS float*)(C.lds);
    LAS unsigned* SELMs = (LAS unsigned*)(C.lds + 1024);
    LAS float* EDGE = (LAS float*)(C.lds + 1024 + 64);
    LAS float* PART = (LAS float*)(C.lds + 2048);
    bf16x8 bq[2];
    { const bf16* qp = WSP(bf16, WS_Q) + ((size_t)rowq * 8 + head) * 64 + 8 * fq; bq[0] = *(const bf16x8*)qp; bq[1] = *(const bf16x8*)(qp + 32); }
    const float* gn = WSP(float, WS_GN) + (size_t)rowq * 24 + head * 3;
    const float g_c = gn[0], g_s = gn[1], g_w = gn[2];
    const SrcB csrc{WSP(bf16, WS_CMPKS) + (size_t)(b * 2 + kvh) * 65536, WSP(bf16, WS_CMPVS) + (size_t)(b * 2 + kvh) * 65536, 1024};
    constexpr int NVIS = 1023;
    float m = -1e30f, l = 0.f;
#pragma unroll 2
    for (int i = 0; i < 4; ++i) { const int kb = 32 * (w + 8 * i);
        bf16x8 kf[2][2]; load_k(csrc, kb, lane, kf);
        f4 s0, s1; qk_scores(kf, bq, s0, s1);
        float mx = -1e30f;
#pragma unroll
        for (int j = 0; j < 4; ++j) { mx = fmaxf(mx, (kb + 8 * fq + j < NVIS) ? s0[j] : -1e30f); mx = fmaxf(mx, (kb + 8 * fq + 4 + j < NVIS) ? s1[j] : -1e30f); }
        if (__any(mx > m + MAX_SLACK)) { mx = fmaxf(mx, __shfl_xor(mx, 16)); mx = fmaxf(mx, __shfl_xor(mx, 32)); const float mn = fmaxf(m, mx); l *= fexp2(m - mn); m = mn; }
#pragma unroll
        for (int j = 0; j < 4; ++j) { l += (kb + 8 * fq + j < NVIS) ? fexp2(s0[j] - m) : 0.f; l += (kb + 8 * fq + 4 + j < NVIS) ? fexp2(s1[j] - m) : 0.f; } }
    PART[(w * 64 + lane) * 40 + 0] = m; PART[(w * 64 + lane) * 40 + 1] = l;
    __syncthreads();
    float M = -1e30f, L = 0.f;
#pragma unroll
    for (int ww = 0; ww < 8; ++ww) M = fmaxf(M, PART[(ww * 64 + lane) * 40]);
#pragma unroll
    for (int ww = 0; ww < 8; ++ww) L += PART[(ww * 64 + lane) * 40 + 1] * fexp2(PART[(ww * 64 + lane) * 40] - M);
    L = col_total(L); const float il = L > 0.f ? 1.0f / L : 0.f;
    __syncthreads();
    {
        f4 o[4];
#pragma unroll
        for (int c = 0; c < 4; ++c) o[c] = (f4){0.f, 0.f, 0.f, 0.f};
#pragma unroll 1
        for (int i = 0; i < 4; ++i) { const int kb = 32 * (w + 8 * i);
            bf16x8 kf[2][2], vf[4]; load_k(csrc, kb, lane, kf); load_v(csrc, kb, lane, vf);
            f4 s0, s1; qk_scores(kf, bq, s0, s1);
            f4 p0, p1;
#pragma unroll
            for (int j = 0; j < 4; ++j) { p0[j] = (kb + 8 * fq + j < NVIS) ? fexp2(s0[j] - M) * il : 0.f; p1[j] = (kb + 8 * fq + 4 + j < NVIS) ? fexp2(s1[j] - M) * il : 0.f; }
            const bf16x8 pb = pack8(p0, p1);
#pragma unroll
            for (int c = 0; c < 4; ++c) o[c] = MFMA16(vf[c], pb, o[c]);
            const float tcur = p1[3];
            const float up_same = __shfl(tcur, (lane + 48) & 63);
            float g0 = (p0[0] + p0[1]) + (p0[2] + p0[3]) + (fq ? up_same : 0.f);
            float g1 = (p1[0] + p1[1]) + (p1[2] + p1[3]) + p0[3];
            float ed = tcur;
            g0 += __shfl_xor(g0, 1); g0 += __shfl_xor(g0, 2); g1 += __shfl_xor(g1, 1); g1 += __shfl_xor(g1, 2); ed += __shfl_xor(ed, 1); ed += __shfl_xor(ed, 2);
            const int jb = (kb >> 2) + 2 * fq;
            SCs[jb] = g0; SCs[jb + 1] = g1;
            EDGE[fq == 3 ? (kb >> 5) : 32] = ed;
        }
#pragma unroll
        for (int c = 0; c < 4; ++c) *(LAS f4*)(PART + (w * 64 + lane) * 40 + 4 + 4 * c) = o[c];
    }
    __syncthreads();
    if (w == 0) {
        if (lane >= 1 && lane < 32) SCs[8 * lane] += EDGE[lane - 1];
#pragma unroll
        for (int c = 0; c < 4; ++c) { f4 o = (f4){0.f, 0.f, 0.f, 0.f};
#pragma unroll
            for (int ww = 0; ww < 8; ++ww) o += *(const LAS f4*)(PART + (ww * 64 + lane) * 40 + 4 + 4 * c);
            *(LAS f4*)(C.lds + 86016 + (c * 64 + lane) * 16) = o * g_c; }
        WAVE_SYNC();
        select_blocks(SCs, SELMs, 254, 255, 255, lane);
    }
    __syncthreads();
    AttnAcc as_, aw; attn_init(as_); attn_init(aw);
    {
        int rank = 0;
#pragma unroll 1
        for (int wd = 0; wd < 8; ++wd) { unsigned uw = (unsigned)__builtin_amdgcn_readfirstlane((int)SELMs[wd]);
            while (uw) { const int bit = __builtin_ctz(uw); uw &= uw - 1u; const int blk = 32 * wd + bit;
                if ((rank & 7) == w) {
                    const int phys = ((const int*)C.in[8])[b * 128 + (blk >> 1)];
                    const SrcF src{C.in[5] + ((size_t)phys * 128 + (size_t)(blk & 1) * 64) * 256, kvh * 64, 128 + kvh * 64, 64};
                    attn_range(as_, src, bq, 0, 64, lane, [&](int) { return true; }); }
                ++rank; } }
        const SrcF wsrc{C.out + O_WINS + (size_t)b * 512 * 256, kvh * 64, 128 + kvh * 64, 512};
        attn_range(aw, wsrc, bq, 64 * w, 64 * w + 64, lane, [&](int) { return true; });
    }
    { LAS float* p = PART + (w * 64 + lane) * 40; p[0] = as_.m; p[1] = as_.l; p[20] = aw.m; p[21] = aw.l;
#pragma unroll
      for (int c = 0; c < 4; ++c) { *(LAS f4*)(p + 4 + 4 * c) = as_.o[c]; *(LAS f4*)(p + 24 + 4 * c) = aw.o[c]; } }
    __syncthreads();
    if (w == 0) {
        f4 outv[4];
#pragma unroll
        for (int c = 0; c < 4; ++c) outv[c] = *(const LAS f4*)(C.lds + 86016 + (c * 64 + lane) * 16);
        float xm; f4 xo[4];
        { const bf16* kp = WSP(bf16, WS_KS) + ((size_t)kvh * RP + rowq) * 64 + 8 * fq; const v4u k0 = *(const v4u*)kp, k1 = *(const v4u*)(kp + 32);
          f4 ka, kb2, kc, kd, qa, qb2, qc, qd; bf8_to_f(k0, ka, kb2); bf8_to_f(k1, kc, kd); bf8_to_f(__builtin_bit_cast(v4u, bq[0]), qa, qb2); bf8_to_f(__builtin_bit_cast(v4u, bq[1]), qc, qd);
          const f4 pr = qa * ka + qb2 * kb2 + qc * kc + qd * kd; xm = col_total((pr[0] + pr[1]) + (pr[2] + pr[3]));
          const bf16* vp = WSP(bf16, WS_VST) + ((size_t)kvh * 64 + 4 * fq) * RP + rowq;
#pragma unroll
          for (int c = 0; c < 4; ++c)
#pragma unroll
              for (int j = 0; j < 4; ++j) xo[c][j] = bf2f(vp[(size_t)(16 * c + j) * RP]); }
        const f4 zo[4] = {{0.f, 0.f, 0.f, 0.f}, {0.f, 0.f, 0.f, 0.f}, {0.f, 0.f, 0.f, 0.f}, {0.f, 0.f, 0.f, 0.f}};
        merge_parts(PART, lane, 0, g_s, outv, xm, fq == 0 ? 1.0f : 0.0f, xo); merge_parts(PART, lane, 20, g_w, outv, -1e30f, 0.f, zo);
        if ((r >> 2) == 0) { bf16* od = WSP(bf16, WS_ONSA) + (size_t)rowq * 512 + head * 64 + 4 * fq;
#pragma unroll
            for (int c = 0; c < 4; ++c) { v2u wv; wv.x = cvtpk(outv[c][0], outv[c][1]); wv.y = cvtpk(outv[c][2], outv[c][3]); *(v2u*)(od + 16 * c) = wv; } }
    }
    __syncthreads();
}

struct TileSrc { const bf16* K; const bf16* VT; int pitch; };
__device__ __forceinline__ void tile_fetch(const TileSrc& s, int kb, int tid, v4u& rk, v4u& rv) {
    const int row = tid >> 3, c = tid & 7;
    rk = *(const v4u*)(s.K + (size_t)(kb + row) * 64 + 8 * c);
    rv = *(const v4u*)(s.VT + (size_t)row * s.pitch + kb + 8 * c);
}
__device__ __forceinline__ void tile_store(LAS unsigned char* buf, int tid, const v4u& rk, const v4u& rv) {
    const int row = tid >> 3, c = tid & 7;
    const int kap = row & 31, rho = (row & 32) + 16 * ((kap >> 2) & 1) + 4 * (kap >> 3) + (kap & 3);
    *(LAS v4u*)(buf + rho * 128 + 16 * (c ^ ((rho >> 1) & 7))) = rk;
    *(LAS v4u*)(buf + 8192 + row * 128 + 16 * (c ^ ((row >> 1) & 7))) = rv;
}
__device__ __forceinline__ void tile_read_k(const LAS unsigned char* buf, int ch, int lane, bf16x8 (&kf)[2][2]) {
    const int r = lane & 15, fq = lane >> 4;
#pragma unroll
    for (int kt = 0; kt < 2; ++kt) { const int rho = 32 * ch + 16 * kt + r;
#pragma unroll
        for (int s = 0; s < 2; ++s) kf[kt][s] = *(const LAS bf16x8*)(buf + rho * 128 + 16 * ((4 * s + fq) ^ ((rho >> 1) & 7))); }
}
__device__ __forceinline__ void tile_read_v(const LAS unsigned char* buf, int ch, int lane, bf16x8 (&vf)[4]) {
    const int r = lane & 15, fq = lane >> 4;
#pragma unroll
    for (int cc = 0; cc < 4; ++cc) { const int d = 16 * cc + r; vf[cc] = *(const LAS bf16x8*)(buf + 8192 + d * 128 + 16 * ((4 * ch + fq) ^ ((d >> 1) & 7))); }
}
template <int STG, class F>
__device__ __forceinline__ void stream_tiles(Ctx& C, const TileSrc& src, int tile0, int ntiles, LAS unsigned char* bufs, F&& compute) {
    if (ntiles <= 0) return;
    const int nst = (ntiles + STG - 1) / STG, tlast = tile0 + ntiles - 1;
    v4u rk[STG], rv[STG];
    { const int tidl = launder_v(C.tid);
#pragma unroll
      for (int h = 0; h < STG; ++h) { const int t = tile0 + h; tile_fetch(src, 64 * (t < tlast ? t : tlast), tidl, rk[h], rv[h]); }
#pragma unroll
      for (int h = 0; h < STG; ++h) tile_store(bufs + h * 16384, tidl, rk[h], rv[h]); }
    __syncthreads();
#pragma unroll 1
    for (int st = 0; st < nst; ++st) {
        const int tidl = launder_v(C.tid);
        const bool more = st + 1 < nst;
        if (more) {
#pragma unroll
            for (int h = 0; h < STG; ++h) { const int t = tile0 + STG * (st + 1) + h; tile_fetch(src, 64 * (t < tlast ? t : tlast), tidl, rk[h], rv[h]); } }
        LAS unsigned char* cur = bufs + (st & 1) * (STG * 16384);
#pragma unroll 1
        for (int h = 0; h < STG; ++h) if (STG * st + h < ntiles) compute(cur + h * 16384, tile0 + STG * st + h);
        if (more) {
#pragma unroll
            for (int h = 0; h < STG; ++h) tile_store(bufs + ((st + 1) & 1) * (STG * 16384) + h * 16384, tidl, rk[h], rv[h]); }
        __syncthreads();
    }
}
__device__ __forceinline__ void nsa_block_task(Ctx& C, int task, bf16* ONSA_OUT) {
    const int lane = C.lane, r = lane & 15, fq = lane >> 4, qi = r >> 2, g = r & 3, w = C.wave;
    const int kvh = task >= 256 ? 1 : 0, qb = task >= 256 ? 511 - task : task, t0 = 64 * qb;
    LAS unsigned char* bufs = C.lds;
    LAS float* SC = (LAS float*)(C.lds + 65536 + w * 8448);
    LAS unsigned* SELM = (LAS unsigned*)(C.lds + 133120 + w * 256);
    const int head = kvh * 4 + g;
    int tl[2]; bf16x8 bq[2][2]; float g_c[2], g_s[2], g_w[2];
#pragma unroll
    for (int cg = 0; cg < 2; ++cg) { tl[cg] = t0 + 8 * w + 4 * cg + qi;
        const bf16* qp = WSP(bf16, WS_Q) + ((size_t)tl[cg] * 8 + head) * 64 + 8 * fq; bq[cg][0] = *(const bf16x8*)qp; bq[cg][1] = *(const bf16x8*)(qp + 32);
        const float* gn = WSP(float, WS_GN) + (size_t)tl[cg] * 24 + head * 3; g_c[cg] = gn[0]; g_s[cg] = gn[1]; g_w[cg] = gn[2]; }
    f4 oc[2][4];
    {
        const int kvc = launder_s(kvh);
        const TileSrc src{WSP(bf16, WS_CMPKP) + (size_t)kvc * 65536, WSP(bf16, WS_CMPVP) + (size_t)kvc * 65536, 1024};
        int nvis[2];
#pragma unroll
        for (int cg = 0; cg < 2; ++cg) nvis[cg] = tl[cg] >= 31 ? ((tl[cg] - 31) >> 4) + 1 : 0;
        const int twmax = t0 + 8 * w + 7; const int nvw = twmax >= 31 ? ((twmax - 31) >> 4) + 1 : 0;
        const int nvb = ((t0 + 63 - 31) >> 4) + 1;
        const int ntile = (nvb + 63) >> 6;
        float m[2] = {-1e30f, -1e30f}, l[2] = {0.f, 0.f};
        stream_tiles<2>(C, src, 0, ntile, bufs, [&](const LAS unsigned char* buf, int j) {
#pragma unroll
            for (int ch = 0; ch < 2; ++ch) { const int kb = 64 * j + 32 * ch; if (kb >= nvw) continue;
                bf16x8 kf[2][2]; tile_read_k(buf, ch, launder_v(lane), kf);
#pragma unroll
                for (int cg = 0; cg < 2; ++cg) {
                    f4 s0, s1;
#pragma unroll
                    for (int jj = 0; jj < 4; ++jj) { s0[jj] = (kb + 8 * fq + jj < nvis[cg]) ? 0.f : -3e30f; s1[jj] = (kb + 8 * fq + 4 + jj < nvis[cg]) ? 0.f : -3e30f; }
                    s0 = MFMA16(kf[0][0], bq[cg][0], s0); s0 = MFMA16(kf[0][1], bq[cg][1], s0); s1 = MFMA16(kf[1][0], bq[cg][0], s1); s1 = MFMA16(kf[1][1], bq[cg][1], s1);
                    float mx = fmaxf(fmaxf(fmaxf(s0[0], s0[1]), fmaxf(s0[2], s0[3])), fmaxf(fmaxf(s1[0], s1[1]), fmaxf(s1[2], s1[3])));
                    if (__any(mx > m[cg] + MAX_SLACK)) { mx = fmaxf(mx, __shfl_xor(mx, 16)); mx = fmaxf(mx, __shfl_xor(mx, 32));
                        const float mn = fmaxf(m[cg], mx); l[cg] *= fexp2(m[cg] - mn); m[cg] = mn; }
                    float ps = 0.f;
#pragma unroll
                    for (int jj = 0; jj < 4; ++jj) ps += fexp2(s0[jj] - m[cg]) + fexp2(s1[jj] - m[cg]);
                    l[cg] += ps;
                } }
        });
        float il[2];
#pragma unroll
        for (int cg = 0; cg < 2; ++cg) { const float lt = col_total(l[cg]); il[cg] = lt > 0.f ? 1.0f / lt : 0.f; }
#pragma unroll
        for (int i = 0; i < 32; ++i) SC[lane * 32 + i] = 0.f;
        WAVE_SYNC();
        f4 o[2][4];
#pragma unroll
        for (int cg = 0; cg < 2; ++cg)
#pragma unroll
            for (int c = 0; c < 4; ++c) o[cg][c] = (f4){0.f, 0.f, 0.f, 0.f};
        float tprev[2] = {0.f, 0.f};
        stream_tiles<2>(C, src, 0, ntile, bufs, [&](const LAS unsigned char* buf, int j) {
#pragma unroll
            for (int ch = 0; ch < 2; ++ch) { const int kb = 64 * j + 32 * ch; if (kb >= nvw) continue;
                const int ll = launder_v(lane), fq2 = ll >> 4, qi2 = (ll >> 2) & 3;
                bf16x8 kf[2][2], vf[4]; { tile_read_k(buf, ch, ll, kf); tile_read_v(buf, ch, ll, vf); }
#pragma unroll
                for (int cg = 0; cg < 2; ++cg) {
                    f4 s0, s1;
#pragma unroll
                    for (int jj = 0; jj < 4; ++jj) { s0[jj] = (kb + 8 * fq + jj < nvis[cg]) ? 0.f : -3e30f; s1[jj] = (kb + 8 * fq + 4 + jj < nvis[cg]) ? 0.f : -3e30f; }
                    s0 = MFMA16(kf[0][0], bq[cg][0], s0); s0 = MFMA16(kf[0][1], bq[cg][1], s0); s1 = MFMA16(kf[1][0], bq[cg][0], s1); s1 = MFMA16(kf[1][1], bq[cg][1], s1);
                    f4 p0, p1;
#pragma unroll
                    for (int jj = 0; jj < 4; ++jj) { p0[jj] = fexp2(s0[jj] - m[cg]) * il[cg]; p1[jj] = fexp2(s1[jj] - m[cg]) * il[cg]; }
                    const bf16x8 pb = pack8(p0, p1);
#pragma unroll
                    for (int c = 0; c < 4; ++c) o[cg][c] = MFMA16(vf[c], pb, o[cg][c]);
                    const float tcur = p1[3];
                    const float up_same = __shfl(tcur, (ll + 48) & 63), up_prev = __shfl(tprev[cg], (ll + 48) & 63);
                    tprev[cg] = tcur;
                    float g0 = (p0[0] + p0[1]) + (p0[2] + p0[3]) + (fq2 ? up_same : up_prev);
                    float g1 = (p1[0] + p1[1]) + (p1[2] + p1[3]) + p0[3];
                    g0 += __shfl_xor(g0, 1); g0 += __shfl_xor(g0, 2); g1 += __shfl_xor(g1, 1); g1 += __shfl_xor(g1, 2);
                    { const int jb = (kb >> 2) + 2 * fq2; SC[(4 * cg + qi2) * 256 + jb] = g0; SC[(4 * cg + qi2) * 256 + jb + 1] = g1; }
                } }
        });
#pragma unroll
        for (int cg = 0; cg < 2; ++cg)
#pragma unroll
            for (int c = 0; c < 4; ++c) oc[cg][c] = o[cg][c] * g_c[cg];
    }
    WAVE_SYNC();
    {
#pragma unroll 1
        for (int q = 0; q < 8; ++q) {
            if (qb < 16) { if (lane < 8) SELM[q * 8 + lane] = (lane == 0) ? ((1u << (qb + 1)) - 1u) : 0u; }
            else select_blocks(SC + q * 256, SELM + q * 8, qb - 2, qb, qb - 1, lane);
        }
    }
    WAVE_SYNC();
    LAS unsigned* ANYM = (LAS unsigned*)(C.lds + 135168 + w * 64);
    { const int la = launder_v(lane); if (la < 16) { const int cgx = la >> 3, w8 = la & 7; ANYM[la] = SELM[(4 * cgx + 0) * 8 + w8] | SELM[(4 * cgx + 1) * 8 + w8] | SELM[(4 * cgx + 2) * 8 + w8] | SELM[(4 * cgx + 3) * 8 + w8]; } }
    WAVE_SYNC();
    f4* STASH = WSP(f4, WS_STASH) + (size_t)(C.bid * NWAVES + w) * 512;
#pragma unroll
    for (int cg = 0; cg < 2; ++cg)
#pragma unroll
        for (int c = 0; c < 4; ++c) STASH[(cg * 4 + c) * 64 + lane] = oc[cg][c];
    __syncthreads();
    {
        AttnAcc a[2]; attn_init(a[0]); attn_init(a[1]);
        const int kvs = launder_s(kvh);
        const TileSrc src{WSP(bf16, WS_KS) + (size_t)kvs * RP * 64, WSP(bf16, WS_VST) + (size_t)kvs * 64 * RP, RP};
        int cw = -1; unsigned aw0 = 0u, aw1 = 0u;
        stream_tiles<4>(C, src, 0, qb, bufs, [&](const LAS unsigned char* buf, int j) {
            if ((j >> 5) != cw) { cw = j >> 5; aw0 = (unsigned)__builtin_amdgcn_readfirstlane((int)ANYM[cw]); aw1 = (unsigned)__builtin_amdgcn_readfirstlane((int)ANYM[8 + cw]); }
            bool any[2]; any[0] = (aw0 >> (j & 31)) & 1u; any[1] = (aw1 >> (j & 31)) & 1u;
            if (any[0] || any[1]) {
                bool mysel[2];
#pragma unroll
                for (int cg = 0; cg < 2; ++cg) mysel[cg] = (SELM[(4 * cg + qi) * 8 + (j >> 5)] >> (j & 31)) & 1u;
                bf16x8 kf[2][2][2], vf[2][4]; { const int ll = launder_v(lane);
#pragma unroll
                    for (int ch = 0; ch < 2; ++ch) { tile_read_k(buf, ch, ll, kf[ch]); tile_read_v(buf, ch, ll, vf[ch]); } }
#pragma unroll
                for (int cg = 0; cg < 2; ++cg) if (any[cg]) attn_tile64_full(a[cg], kf, vf, bq[cg], mysel[cg] ? 0.f : -3e30f);
            }
        });
        stream_tiles<1>(C, src, qb, 1, bufs, [&](const LAS unsigned char* buf, int j) {
            bf16x8 kf[2][2][2], vf[2][4]; { const int ll = launder_v(lane);
#pragma unroll
                for (int ch = 0; ch < 2; ++ch) { tile_read_k(buf, ch, ll, kf[ch]); tile_read_v(buf, ch, ll, vf[ch]); } }
#pragma unroll
            for (int cg = 0; cg < 2; ++cg) { const int tq = tl[cg];
                attn_tile64(a[cg], kf, vf, bq[cg], 64 * j, fq, [&](int key) { return key <= tq; }); }
        });
#pragma unroll
        for (int cg = 0; cg < 2; ++cg) { const float lt = col_total(a[cg].l); const float sc = lt > 0.f ? g_s[cg] / lt : 0.f;
#pragma unroll
            for (int c = 0; c < 4; ++c) STASH[(cg * 4 + c) * 64 + lane] += a[cg].o[c] * sc; }
    }
    {
        AttnAcc a[2]; attn_init(a[0]); attn_init(a[1]);
        const int kvw = launder_s(kvh);
        const TileSrc src{WSP(bf16, WS_KW) + (size_t)kvw * RP * 64, WSP(bf16, WS_VWT) + (size_t)kvw * 64 * RP, RP};
        const int j0 = qb > 8 ? qb - 8 : 0;
        const int twmin = t0 + 8 * w, twmax = twmin + 7;
        stream_tiles<4>(C, src, j0, qb + 1 - j0, bufs, [&](const LAS unsigned char* buf, int j) {
            const int kb = 64 * j;
            if (kb > twmax || kb + 63 <= twmin - 512) return;
            bf16x8 kf[2][2][2], vf[2][4]; { const int ll = launder_v(lane);
#pragma unroll
                for (int ch = 0; ch < 2; ++ch) { tile_read_k(buf, ch, ll, kf[ch]); tile_read_v(buf, ch, ll, vf[ch]); } }
            const bool interior = (kb + 63 <= twmin) && (kb > twmax - 512);
#pragma unroll
            for (int cg = 0; cg < 2; ++cg) { const int tq = tl[cg];
                if (interior) attn_tile64_full(a[cg], kf, vf, bq[cg]);
                else attn_tile64(a[cg], kf, vf, bq[cg], kb, fq, [&](int key) { return key <= tq && key > tq - 512; }); }
        });
#pragma unroll
        for (int cg = 0; cg < 2; ++cg) { const float lt = col_total(a[cg].l); const float sc = lt > 0.f ? g_w[cg] / lt : 0.f;
        bf16* od = ONSA_OUT + (size_t)tl[cg] * 512 + head * 64 + 4 * fq;
#pragma unroll
            for (int c = 0; c < 4; ++c) { const f4 ov = STASH[(cg * 4 + c) * 64 + lane] + a[cg].o[c] * sc;
                v2u wv; wv.x = cvtpk(ov[0], ov[1]); wv.y = cvtpk(ov[2], ov[3]); *(v2u*)(od + 16 * c) = wv; } }
    }
    __syncthreads();
}

__device__ __forceinline__ void ret_u_task(Ctx& C, int task) {
    const int lane = C.lane, r = lane & 15, fq = lane >> 4;
    const int eq = task & 3, h = (task >> 2) & 3, c = task >> 4;
    const bf16* VT = WSP(bf16, WS_RVT) + ((size_t)(h * 256 + 64 * eq + r)) * RP + 128 * c + 8 * fq;
    const bf16* KT = WSP(bf16, WS_RKIT) + ((size_t)(h * 128 + r)) * RP + 128 * c + 8 * fq;
    f4 acc[4][8];
#pragma unroll
    for (int et = 0; et < 4; ++et)
#pragma unroll
        for (int dt = 0; dt < 8; ++dt) acc[et][dt] = (f4){0.f, 0.f, 0.f, 0.f};
#pragma unroll 1
    for (int s2 = 0; s2 < 4; s2 += 2) {
        bf16x8 a[2][4], bb[2][8];
#pragma unroll
        for (int u2 = 0; u2 < 2; ++u2) {
#pragma unroll
            for (int et = 0; et < 4; ++et) a[u2][et] = *(const bf16x8*)(VT + (size_t)(16 * et) * RP + 32 * (s2 + u2));
#pragma unroll
            for (int dt = 0; dt < 8; ++dt) bb[u2][dt] = *(const bf16x8*)(KT + (size_t)(16 * dt) * RP + 32 * (s2 + u2)); }
#pragma unroll
        for (int u2 = 0; u2 < 2; ++u2)
#pragma unroll
            for (int et = 0; et < 4; ++et)
#pragma unroll
                for (int dt = 0; dt < 8; ++dt) acc[et][dt] = MFMA16(bb[u2][dt], a[u2][et], acc[et][dt]);
    }
#if 0
    for (int s = 0; s < 4; ++s) {
        bf16x8 a[4], bb[8];
#pragma unroll
        for (int et = 0; et < 4; ++et) a[et] = *(const bf16x8*)(VT + (size_t)(16 * et) * RP + 32 * s);
#pragma unroll
        for (int dt = 0; dt < 8; ++dt) bb[dt] = *(const bf16x8*)(KT + (size_t)(16 * dt) * RP + 32 * s);
#pragma unroll
        for (int et = 0; et < 4; ++et)
#pragma unroll
            for (int dt = 0; dt < 8; ++dt) acc[et][dt] = MFMA16(bb[dt], a[et], acc[et][dt]);
    }
#endif
    float* U = WSP(float, WS_U) + ((size_t)(c * 4 + h) * 256 + 64 * eq) * 128;
#pragma unroll
    for (int et = 0; et < 4; ++et)
#pragma unroll
        for (int dt = 0; dt < 8; ++dt)
            *(f4*)(U + (size_t)(16 * et + r) * 128 + 16 * dt + 4 * fq) = acc[et][dt];
}
__device__ __forceinline__ void ret_scan(Ctx& C, int nsb) {
    const float* U = WSP(float, WS_U); bf16* SP = WSP(bf16, WS_SPREV); const float* gp = WSP(float, WS_GPOW);
    for (int idx0 = C.bid * 512 + C.tid; idx0 < 32768; idx0 += nsb * 512) {
        const int e = (idx0 >> 7) & 255, d = idx0 & 127;
        float g128[4], S[4];
#pragma unroll
        for (int j = 0; j < 4; ++j) { g128[j] = gp[j * 132 + 128]; S[j] = 0.f; }
#pragma unroll 1
        for (int c0 = 0; c0 < 128; c0 += 16) {
            float u[4][16];
#pragma unroll
            for (int k = 0; k < 16; ++k)
#pragma unroll
                for (int j = 0; j < 4; ++j) u[j][k] = __builtin_nontemporal_load(U + (size_t)(c0 + k) * 131072 + j * 32768 + idx0);
#pragma unroll
            for (int k = 0; k < 16; ++k)
#pragma unroll
                for (int j = 0; j < 4; ++j) { SP[(size_t)(c0 + k) * 131072 + j * 32768 + idx0] = bf1(S[j]); S[j] = g128[j] * (S[j] + u[j][k]); }
        }
#pragma unroll
        for (int j = 0; j < 4; ++j) C.out[O_STP + ((size_t)j * 128 + d) * 256 + e] = S[j];
    }
}
__device__ __forceinline__ void ret_out_task(Ctx& C, int task) {
    const int lane = C.lane, r = lane & 15, fq = lane >> 4;
    const int ig2 = task & 3, h = (task >> 2) & 3, c = task >> 4;
    const int i0 = 128 * c + 32 * ig2;
    bf16x8 bq[2][4];
#pragma unroll
    for (int g = 0; g < 2; ++g) { const bf16* qp = WSP(bf16, WS_RQD) + ((size_t)(i0 + 16 * g + r) * 4 + h) * 128 + 8 * fq;
#pragma unroll
        for (int s = 0; s < 4; ++s) bq[g][s] = *(const bf16x8*)(qp + 32 * s); }
    f4 o[2][16];
#pragma unroll
    for (int g = 0; g < 2; ++g)
#pragma unroll
        for (int et = 0; et < 16; ++et) o[g][et] = (f4){0.f, 0.f, 0.f, 0.f};
    { const bf16* sp = WSP(bf16, WS_SPREV) + ((size_t)(c * 4 + h) * 256 + r) * 128 + 8 * fq;
#pragma unroll
      for (int et = 0; et < 16; ++et) { bf16x8 a[4];
#pragma unroll
          for (int s = 0; s < 4; ++s) a[s] = *(const bf16x8*)(sp + (size_t)(16 * et) * 128 + 32 * s);
#pragma unroll
          for (int s = 0; s < 4; ++s) { o[0][et] = MFMA16(a[s], bq[0][s], o[0][et]); o[1][et] = MFMA16(a[s], bq[1][s], o[1][et]); } } }
#pragma unroll 1
    for (int jc = 0; jc <= ig2; ++jc) {
        bf16x8 kf[2][4];
#pragma unroll
        for (int kt = 0; kt < 2; ++kt) { const bf16* kp = WSP(bf16, WS_RKI) + ((size_t)(128 * c + 32 * jc + 8 * (r >> 2) + 4 * kt + (r & 3)) * 4 + h) * 128 + 8 * fq;
#pragma unroll
            for (int s = 0; s < 4; ++s) kf[kt][s] = *(const bf16x8*)(kp + 32 * s); }
        bf16x8 pb[2];
#pragma unroll
        for (int g = 0; g < 2; ++g) { f4 s0 = (f4){0.f, 0.f, 0.f, 0.f}, s1 = s0;
#pragma unroll
            for (int s = 0; s < 4; ++s) { s0 = MFMA16(kf[0][s], bq[g][s], s0); s1 = MFMA16(kf[1][s], bq[g][s], s1); }
            const int i = 32 * ig2 + 16 * g + r;
#pragma unroll
            for (int j = 0; j < 4; ++j) { s0[j] = (32 * jc + 8 * fq + j > i) ? 0.f : s0[j]; s1[j] = (32 * jc + 8 * fq + 4 + j > i) ? 0.f : s1[j]; }
            pb[g] = pack8(s0, s1); }
        const bf16* vp = WSP(bf16, WS_RVT) + ((size_t)(h * 256 + r)) * RP + 128 * c + 32 * jc + 8 * fq;
#pragma unroll
        for (int et = 0; et < 16; ++et) { const bf16x8 a = *(const bf16x8*)(vp + (size_t)(16 * et) * RP); o[0][et] = MFMA16(a, pb[0], o[0][et]); o[1][et] = MFMA16(a, pb[1], o[1][et]); }
    }
    const float* gw = C.in[17] + h * 256 + 4 * fq; const float* gb = C.in[18] + h * 256 + 4 * fq;
#pragma unroll
    for (int g = 0; g < 2; ++g) {
        float sm = 0.f;
#pragma unroll
        for (int et = 0; et < 16; ++et) sm += (o[g][et][0] + o[g][et][1]) + (o[g][et][2] + o[g][et][3]);
        sm = col_total(sm); const float mu = sm * (1.0f / 256.0f);
        float q = 0.f;
#pragma unroll
        for (int et = 0; et < 16; ++et) { const f4 dlt = o[g][et] - mu; q += (dlt[0] * dlt[0] + dlt[1] * dlt[1]) + (dlt[2] * dlt[2] + dlt[3] * dlt[3]); }
        q = col_total(q); const float rstd = 1.0f / sqrtf(q * (1.0f / 256.0f) + 1e-5f);
        const size_t ro = (size_t)(i0 + 16 * g + r) * 1024 + h * 256 + 4 * fq;
#pragma unroll
        for (int et = 0; et < 16; ++et) {
            const f4 y = (o[g][et] - mu) * rstd * *(const f4*)(gw + 16 * et) + *(const f4*)(gb + 16 * et);
            const v2u sg = *(const v2u*)(WSP(bf16, WS_SRG) + ro + 16 * et);
            const float z0 = y[0] * __builtin_bit_cast(float, sg.x << 16), z1 = y[1] * __builtin_bit_cast(float, sg.x & 0xffff0000u),
                        z2 = y[2] * __builtin_bit_cast(float, sg.y << 16), z3 = y[3] * __builtin_bit_cast(float, sg.y & 0xffff0000u);
            v2u w; w.x = cvtpk(z0, z1); w.y = cvtpk(z2, z3); *(v2u*)(WSP(bf16, WS_YRET) + ro + 16 * et) = w;
        }
    }
}
__device__ __forceinline__ void ret_out_block(Ctx& C, int bt) {
    const int lane = C.lane, r = lane & 15, fq = lane >> 4, w = C.wave;
    const int h = bt & 3, c = bt >> 2, i0 = 128 * c + 16 * w;
    LAS unsigned char* SP = C.lds;
    LAS unsigned char* KI = C.lds + 65536;
    const int l4 = launder_v(lane), rsub = l4 >> 4, pc = l4 & 15;
    { const char* sp = (const char*)(WSP(bf16, WS_SPREV) + (size_t)(c * 4 + h) * 256 * 128);
#pragma unroll
      for (int i = 0; i < 8; ++i) { const int q = w + 8 * i, row = 4 * q + rsub;
          __builtin_amdgcn_global_load_lds((const unsigned*)(sp + row * 256 + 16 * (pc ^ (row & 15))), (LAS unsigned*)(SP + q * 1024), 16, 0, 0); }
      const char* kp = (const char*)(WSP(bf16, WS_RKI) + ((size_t)(128 * c) * 4 + h) * 128);
#pragma unroll
      for (int i = 0; i < 4; ++i) { const int q = w + 8 * i, row = 4 * q + rsub, f = (row & 3) | (((row >> 3) & 3) << 2);
          __builtin_amdgcn_global_load_lds((const unsigned*)(kp + (size_t)row * 1024 + 16 * (pc ^ f)), (LAS unsigned*)(KI + q * 1024), 16, 0, 0); } }
    bf16x8 bq[4];
    { const bf16* qp = WSP(bf16, WS_RQD) + ((size_t)(i0 + r) * 4 + h) * 128 + 8 * fq;
#pragma unroll
      for (int s = 0; s < 4; ++s) bq[s] = *(const bf16x8*)(qp + 32 * s); }
    const size_t ro = (size_t)(i0 + r) * 1024 + h * 256 + 4 * fq;
    v2u sg[16];
#pragma unroll
    for (int et = 0; et < 16; ++et) sg[et] = *(const v2u*)(WSP(bf16, WS_SRG) + ro + 16 * et);
    asm volatile("s_waitcnt vmcnt(0)" ::: "memory");
    __syncthreads();
    f4 o[16];
#pragma unroll
    for (int et = 0; et < 16; ++et) { o[et] = (f4){0.f, 0.f, 0.f, 0.f};
#pragma unroll
        for (int s = 0; s < 4; ++s) { const bf16x8 a = *(const LAS bf16x8*)(SP + (16 * et + r) * 256 + 16 * ((4 * s + fq) ^ r)); o[et] = MFMA16(a, bq[s], o[et]); } }
    const int njc = (w >> 1) + 1;
    bf16x8 pb[4];
#pragma unroll
    for (int jc = 0; jc < 4; ++jc) {
        f4 s0 = (f4){0.f, 0.f, 0.f, 0.f}, s1 = s0;
        if (jc < njc) {
#pragma unroll
            for (int kt = 0; kt < 2; ++kt) { const int kk = 32 * jc + 8 * (r >> 2) + 4 * kt + (r & 3);
#pragma unroll
                for (int s = 0; s < 4; ++s) { const bf16x8 kf = *(const LAS bf16x8*)(KI + kk * 256 + 16 * ((4 * s + fq) ^ r));
                    if (kt == 0) s0 = MFMA16(kf, bq[s], s0); else s1 = MFMA16(kf, bq[s], s1); } }
            const int i = 16 * w + r;
#pragma unroll
            for (int j = 0; j < 4; ++j) { s0[j] = (32 * jc + 8 * fq + j > i) ? 0.f : s0[j]; s1[j] = (32 * jc + 8 * fq + 4 + j > i) ? 0.f : s1[j]; }
        }
        pb[jc] = pack8(s0, s1);
    }
    __syncthreads();
    { const char* vp = (const char*)(WSP(bf16, WS_RVT) + (size_t)(h * 256) * RP + 128 * c);
#pragma unroll
      for (int i = 0; i < 8; ++i) { const int q = w + 8 * i, row = 4 * q + rsub;
          __builtin_amdgcn_global_load_lds((const unsigned*)(vp + (size_t)row * (RP * 2) + 16 * (pc ^ (row & 15))), (LAS unsigned*)(SP + q * 1024), 16, 0, 0); } }
    asm volatile("s_waitcnt vmcnt(0)" ::: "memory");
    __syncthreads();
#pragma unroll
    for (int jc = 0; jc < 4; ++jc)
        if (jc < njc) {
#pragma unroll
            for (int et = 0; et < 16; ++et) { const bf16x8 a = *(const LAS bf16x8*)(SP + (16 * et + r) * 256 + 16 * ((4 * jc + fq) ^ r)); o[et] = MFMA16(a, pb[jc], o[et]); } }
    const float* gw = C.in[17] + h * 256 + 4 * fq; const float* gb = C.in[18] + h * 256 + 4 * fq;
    float sm = 0.f;
#pragma unroll
    for (int et = 0; et < 16; ++et) sm += (o[et][0] + o[et][1]) + (o[et][2] + o[et][3]);
    sm = col_total(sm); const float mu = sm * (1.0f / 256.0f);
    float qv = 0.f;
#pragma unroll
    for (int et = 0; et < 16; ++et) { const f4 dlt = o[et] - mu; qv += (dlt[0] * dlt[0] + dlt[1] * dlt[1]) + (dlt[2] * dlt[2] + dlt[3] * dlt[3]); }
    qv = col_total(qv); const float rstd = 1.0f / sqrtf(qv * (1.0f / 256.0f) + 1e-5f);
#pragma unroll
    for (int hb = 0; hb < 2; ++hb) {
        f4 gwv[8], gbv[8];
#pragma unroll
        for (int e8 = 0; e8 < 8; ++e8) { gwv[e8] = *(const f4*)(gw + 16 * (8 * hb + e8)); gbv[e8] = *(const f4*)(gb + 16 * (8 * hb + e8)); }
#pragma unroll
        for (int e8 = 0; e8 < 8; ++e8) { const int et = 8 * hb + e8;
            const f4 y = (o[et] - mu) * rstd * gwv[e8] + gbv[e8];
            const float z0 = y[0] * __builtin_bit_cast(float, sg[et].x << 16), z1 = y[1] * __builtin_bit_cast(float, sg[et].x & 0xffff0000u),
                        z2 = y[2] * __builtin_bit_cast(float, sg[et].y << 16), z3 = y[3] * __builtin_bit_cast(float, sg[et].y & 0xffff0000u);
            v2u wv; wv.x = cvtpk(z0, z1); wv.y = cvtpk(z2, z3); *(v2u*)(WSP(bf16, WS_YRET) + ro + 16 * et) = wv; }
    }
    __syncthreads();
}
__device__ __forceinline__ void ret_sample_task(Ctx& C, int task) {
    const int b = task >> 2, h = task & 3, row = T + b, lane = C.lane, w = C.wave;
    LAS float* red = (LAS float*)C.lds;
    const bf16* qp = WSP(bf16, WS_RQD) + ((size_t)row * 4 + h) * 128; const bf16* kp = WSP(bf16, WS_RKI) + ((size_t)row * 4 + h) * 128;
    const float gam = WSP(float, WS_GPOW)[h * 132 + 1];
    float qk = bf2f(qp[lane]) * bf2f(kp[lane]) + bf2f(qp[lane + 64]) * bf2f(kp[lane + 64]); qk = wave_sum(qk);
    f4 v4;
#pragma unroll
    for (int j = 0; j < 4; ++j) v4[j] = bf2f(WSP(bf16, WS_RVT)[((size_t)(h * 256 + 4 * lane + j)) * RP + row]);
    f4 po = (f4){0.f, 0.f, 0.f, 0.f};
    const float* S = C.in[7] + ((size_t)(b * 4 + h) * 128) * 256; float* Sn = C.out + O_STS + ((size_t)(b * 4 + h) * 128) * 256;
    { f4 sv[16]; float qd[16], kd[16];
#pragma unroll
      for (int dd = 0; dd < 16; ++dd) { const int d = 16 * w + dd; sv[dd] = __builtin_nontemporal_load((const f4*)(S + (size_t)d * 256) + lane); qd[dd] = bf2f(qp[d]); kd[dd] = bf2f(kp[d]); }
#pragma unroll
      for (int dd = 0; dd < 16; ++dd) { const int d = 16 * w + dd;
          po += sv[dd] * qd[dd]; __builtin_nontemporal_store(sv[dd] * gam + v4 * kd[dd], (f4*)(Sn + (size_t)d * 256) + lane); } }
    *((LAS f4*)(red + w * 256) + lane) = po;
    __syncthreads();
    if (w == 0) {
        f4 o = (f4){0.f, 0.f, 0.f, 0.f};
#pragma unroll
        for (int ww = 0; ww < 8; ++ww) o += *((LAS f4*)(red + ww * 256) + lane);
        o = v4 * qk + o * gam;
        const float mu = wave_sum((o[0] + o[1]) + (o[2] + o[3])) * (1.0f / 256.0f);
        const f4 dl = o - mu; const float var = wave_sum((dl[0] * dl[0] + dl[1] * dl[1]) + (dl[2] * dl[2] + dl[3] * dl[3])) * (1.0f / 256.0f);
        const float rstd = 1.0f / sqrtf(var + 1e-5f);
        const f4 y = dl * rstd * *(const f4*)(C.in[17] + h * 256 + 4 * lane) + *(const f4*)(C.in[18] + h * 256 + 4 * lane);
        const size_t ro = (size_t)row * 1024 + h * 256 + 4 * lane;
        const v2u sg = *(const v2u*)(WSP(bf16, WS_SRG) + ro);
        v2u wv; wv.x = cvtpk(y[0] * __builtin_bit_cast(float, sg.x << 16), y[1] * __builtin_bit_cast(float, sg.x & 0xffff0000u));
        wv.y = cvtpk(y[2] * __builtin_bit_cast(float, sg.y << 16), y[3] * __builtin_bit_cast(float, sg.y & 0xffff0000u));
        *(v2u*)(WSP(bf16, WS_YRET) + ro) = wv;
    }
    __syncthreads();
}

#define XB_TMO      128
#define XB_XCNT(j)  (256  + 64 * (j))
#define XB_XSUB(j)  (1280 + 64 * (j))
#define XB_XGEN(j)  (2304 + 64 * (j))
#define XB_TOP      3328
#define XB_TOPGEN   3392
#define XCD_BAR_WORDS 3456
#define XB_SPIN_CAP (1u << 18)

__device__ __forceinline__ unsigned xb_ld(unsigned* p)              { return __hip_atomic_load(p, __ATOMIC_RELAXED, __HIP_MEMORY_SCOPE_AGENT); }
__device__ __forceinline__ unsigned xb_add(unsigned* p, unsigned v) { return __hip_atomic_fetch_add(p, v, __ATOMIC_RELAXED, __HIP_MEMORY_SCOPE_AGENT); }
__device__ __forceinline__ unsigned xb_xcc_id() { return (unsigned)__builtin_amdgcn_s_getreg((3 << 11) | 20) & 0xFu; }
#define XB_SPIN(cond, bar) do { unsigned _sp = 0; while (cond) { __builtin_amdgcn_s_sleep(1); \
    if ((++_sp & 255u) == 0u) { if (xb_ld(&(bar)[XB_TMO])) break; if (_sp > XB_SPIN_CAP) { atomicAdd(&(bar)[XB_TMO], 1u); break; } } } } while (0)

struct XcdBarrier {
    unsigned* bar; unsigned x; int w;
    volatile LAS unsigned* st;
};

__device__ __forceinline__ XcdBarrier xcd_barrier_post(unsigned* bar, volatile LAS unsigned* st, int wave) {
    XcdBarrier b; b.bar = bar; b.x = xb_xcc_id(); b.st = st; b.w = wave;
    if (wave == 0 && lane_id() == 0) (void)xb_add(&bar[XB_XCNT(b.x)], 1u);
    return b;
}
__device__ __forceinline__ void xcd_barrier_complete(unsigned* bar, unsigned x, unsigned& nloc, unsigned& nx) {
    const unsigned G = gridDim.x * gridDim.y * gridDim.z;
    unsigned sum, cnt, mine, sp = 0u;
    for (;;) {
        sum = 0u; cnt = 0u; mine = 0u;
#pragma unroll
        for (unsigned j = 0; j < 16; ++j) { const unsigned c = xb_ld(&bar[XB_XCNT(j)]); sum += c; cnt += (c > 0u) ? 1u : 0u; mine = (j == x) ? c : mine; }
        if (sum == G) break;
        __builtin_amdgcn_s_sleep(1);
        if ((++sp & 255u) == 0u) { if (xb_ld(&bar[XB_TMO])) break; if (sp > XB_SPIN_CAP) { atomicAdd(&bar[XB_TMO], 1u); break; } }
    }
    nloc = mine > 0u ? mine : 1u; nx = cnt > 0u ? cnt : 1u;
}

__device__ __forceinline__ void xcd_barrier(const XcdBarrier& b) {
    asm volatile("s_waitcnt vmcnt(0)" ::: "memory");
    __syncthreads();
    if (b.w == 0 && lane_id() == 0) {
        unsigned* bar = b.bar;
        __builtin_amdgcn_s_waitcnt(0);
        unsigned nloc = b.st[0], nx = b.st[1];
        if (nloc == 0u) { xcd_barrier_complete(bar, b.x, nloc, nx); b.st[0] = nloc; b.st[1] = nx; }
        const unsigned old = xb_add(&bar[XB_XSUB(b.x)], 1u);
        const unsigned gen = old / nloc;
        if (old + 1u == (gen + 1u) * nloc) {
            __builtin_amdgcn_fence(__ATOMIC_RELEASE, "agent");
            asm volatile("s_waitcnt vmcnt(0)" ::: "memory");
            const unsigned og = xb_add(&bar[XB_TOP], 1u);
            const unsigned tg = og / nx;
            if (og + 1u == (tg + 1u) * nx) xb_add(&bar[XB_TOPGEN], 1u);
            else XB_SPIN(xb_ld(&bar[XB_TOPGEN]) == tg, bar);
            __builtin_amdgcn_fence(__ATOMIC_ACQUIRE, "agent");
            xb_add(&bar[XB_XGEN(b.x)], 1u);
            asm volatile("s_waitcnt vmcnt(0)" ::: "memory");
        } else {
            XB_SPIN(xb_ld(&bar[XB_XGEN(b.x)]) == gen, bar);
            __builtin_amdgcn_fence(__ATOMIC_ACQUIRE, "agent");
            asm volatile("s_waitcnt vmcnt(0)" ::: "memory");
        }
    }
    __syncthreads();
}


__device__ __forceinline__ void chain_barrier(Ctx& C, unsigned* cnt, unsigned target, unsigned* tmo_bar) {
    asm volatile("s_waitcnt vmcnt(0)" ::: "memory");
    __syncthreads();
    if (C.tid == 0) { __builtin_amdgcn_fence(__ATOMIC_RELEASE, "agent"); asm volatile("s_waitcnt vmcnt(0)" ::: "memory"); (void)xb_add(cnt, 1u);
        XB_SPIN(xb_ld(cnt) < target, tmo_bar); __builtin_amdgcn_fence(__ATOMIC_ACQUIRE, "agent"); asm volatile("s_waitcnt vmcnt(0)" ::: "memory"); }
    __syncthreads();
}

struct Args { const float* in[24]; float* out; unsigned char* ws; int ph_lo, ph_hi; };
__global__ void __launch_bounds__(NWAVES * 64, 2) hybrid_fwd(Args args) {
    extern __shared__ __attribute__((aligned(16))) unsigned char lds_raw[];
    Ctx C;
    C.lds = (LAS unsigned char*)lds_raw;
    const int wave_s = __builtin_amdgcn_readfirstlane((int)(threadIdx.x >> 6));
    C.lane = lane_id(); C.wave = wave_s; C.tid = C.wave * 64 + C.lane;
    C.bid = blockIdx.x; C.nb = gridDim.x; C.gw = C.bid * NWAVES + C.wave; C.ngw = C.nb * NWAVES;
    typedef const unsigned long long __attribute__((address_space(4))) * KargP;
    const unsigned long long karg0 = (unsigned long long)__builtin_amdgcn_kernarg_segment_ptr();
#define LOAD_ARGS() do { unsigned long long _k = karg0; asm volatile("" : "+s"(_k)); KargP _p = (KargP)_k; \
        _Pragma("unroll") for (int _i = 0; _i < 24; ++_i) C.in[_i] = (const float*)(GAS const float*)_p[_i]; C.out = (float*)(GAS float*)_p[24]; C.ws = (unsigned char*)(GAS unsigned char*)_p[25]; } while (0)
    LOAD_ARGS();
    volatile LAS unsigned* MISC = (volatile LAS unsigned*)(C.lds + MISC_OFF);
    for (int u = C.tid; u < (LDS_BYTES - MISC_OFF) / 4; u += NWAVES * 64) ((LAS unsigned*)(C.lds + MISC_OFF))[u] = 0u;
    __syncthreads();
    const int lo = args.ph_lo, hi = args.ph_hi;
    XcdBarrier bar; bar.bar = (unsigned*)(C.ws + WS_CTL) + CW_BAR; bar.x = 0; bar.st = nullptr; bar.w = wave_s;
    if (hi - lo > 1) bar = xcd_barrier_post((unsigned*)(C.ws + WS_CTL) + CW_BAR, MISC + 8, wave_s);
#define IN(k) (lo <= (k) && (k) < hi)
#define PHASE_BEGIN() do { LOAD_ARGS(); C.lane = launder_v(lane_id()); C.wave = wave_s; C.tid = C.wave * 64 + C.lane; C.gw = C.bid * NWAVES + C.wave; } while (0)
#define SEAM(k) do { if (IN(k) && IN((k) + 1)) xcd_barrier(bar); } while (0)
    LAS unsigned char* ring = C.lds;

    if (IN(0)) { PHASE_BEGIN();
        phase0(C, 1);
        asm volatile("s_waitcnt vmcnt(0)" ::: "memory");
        __syncthreads();
        { unsigned* ctl = (unsigned*)(C.ws + WS_CTL);
          if (C.tid == 0) { __builtin_amdgcn_fence(__ATOMIC_RELEASE, "agent"); asm volatile("s_waitcnt vmcnt(0)" ::: "memory"); (void)xb_add(ctl + 192, 1u); } }
        phase0(C, 22);
        PHASE_BEGIN();
        { unsigned* ctl = (unsigned*)(C.ws + WS_CTL);
          if (C.tid == 0) { XB_SPIN(xb_ld(ctl + 192) < (unsigned)C.nb, bar.bar); __builtin_amdgcn_fence(__ATOMIC_ACQUIRE, "agent"); asm volatile("s_waitcnt vmcnt(0)" ::: "memory"); }
          __syncthreads();
          const float* MOD = WSP(float, WS_MOD);
#pragma unroll 1
          for (;;) { unsigned t = 0u; if (C.lane == 0) t = xb_add(ctl + 256, 1u);
              t = (unsigned)__builtin_amdgcn_readfirstlane((int)t); if (t >= (unsigned)((T + NBATCH) / 8)) break;
              if (8 * (int)t < T) {
#pragma unroll 1
                  for (int r = 8 * (int)t; r < 8 * (int)t + 8; r += 4)
                      rmsnorm_rows4<true, true, false>(C.in[0] + (size_t)r * 1024, 1024, C.in[9], MOD, MOD + 1024, WSP(bf16, WS_H) + (size_t)r * 1024, 1024, C.lane);
              } else {
#pragma unroll 1
                  for (int r = 8 * (int)t; r < 8 * (int)t + 8; ++r) { const float* md = MOD + (size_t)(r - T + 1) * 6144;
                      rmsnorm_row<true, true>(C.in[1] + (size_t)(r - T) * 1024, C.in[9], md, md + 1024, WSP(bf16, WS_H) + (size_t)r * 1024, C.lane); } } }
        }
    } SEAM(1);
    if (IN(2)) { PHASE_BEGIN();
        pg8::Gemm g{WSP(bf16, WS_H), WSP(bf16, WS_WIN), T, NIN, 1024}; pg8::StaticOrder S; S.init(T, NIN, C.nb, C.bid);
        EpiIn E{C.ws, C.out};
        pg8::gemm_phase<EpiIn, pg8::StaticOrder, false, PG8_SP2>(ring, g, S, E, C.wave);
        skinny_phase(C, g.A, g.Bt, NIN, 1024, E);
        { const int hb = C.nb > 128 ? 128 : 0;
          if (C.bid >= hb) { PHASE_BEGIN(); asm volatile("s_waitcnt vmcnt(0)" ::: "memory"); __syncthreads(); late_prologue(C, (C.bid - hb) * NWAVES + C.wave, (C.nb - hb) * NWAVES); } }
    } SEAM(2);
    if (IN(3)) { PHASE_BEGIN();
        if (C.bid * NWAVES < 128) {
            stage_wcmp(C);
            for (int p = C.gw; p < 128; p += C.ngw) {
                const float* base0 = C.out + O_CMPP + (size_t)p * 128 * 256;
                cmp_build_page(base0, p < 127 ? base0 + 128 * 256 : nullptr, (const LAS float*)C.lds, C.in[16], WSP(bf16, WS_CMPKP), WSP(bf16, WS_CMPVP), p, C.lane); }
            __syncthreads();
        }
        for (int task = C.bid; task < 128; task += C.nb) ret_sample_task(C, task);
        { int t0 = C.bid - (128 % C.nb); if (t0 < 0) t0 += C.nb;
          for (int task = t0; task < 64; task += C.nb) nsa_sample_block(C, task); }
        { unsigned* qhead = (unsigned*)(C.ws + WS_CTL) + 16;
#pragma unroll 1
          for (;;) { unsigned t = 0u; if (C.lane == 0) t = __hip_atomic_fetch_add(qhead, 1u, __ATOMIC_RELAXED, __HIP_MEMORY_SCOPE_AGENT);
              t = (unsigned)__builtin_amdgcn_readfirstlane((int)t); if (t >= 2048u) break; ret_u_task(C, (int)t); } }
    } SEAM(3);
    if (IN(4)) { PHASE_BEGIN();
        unsigned* ctl = (unsigned*)(C.ws + WS_CTL);
        const int NSB = C.nb >= 128 ? 64 : C.nb;
        if (C.bid < NSB) {
            ret_scan(C, NSB);
            asm volatile("s_waitcnt vmcnt(0)" ::: "memory");
            __syncthreads();
            if (C.tid == 0) { __builtin_amdgcn_fence(__ATOMIC_RELEASE, "agent"); asm volatile("s_waitcnt vmcnt(0)" ::: "memory"); (void)xb_add(ctl + 64, 1u); }
        }
        { const int NSC = C.nb < 16 ? C.nb : 16;
          if (C.bid >= C.nb - NSC) {
              const int sb = C.bid - (C.nb - NSC); unsigned gen = 0u;
              { EpiMixA E6{C.ws}; EpiMixed E7{C.ws};
#pragma unroll 1
                for (int su = sb; su < 16; su += NSC) { skinny_subunit(C, WSP(bf16, WS_ONSA), WSP(bf16, WS_WBN), 512, su >> 2, su & 3, E6);
                    skinny_subunit(C, WSP(bf16, WS_YRET), WSP(bf16, WS_WBR), 1024, su >> 2, su & 3, E7); } }
              gen += (unsigned)NSC; chain_barrier(C, ctl + 384, gen, bar.bar);
              { EpiResid E8{C.ws, C.in[0], C.in[1], 2048, true};
#pragma unroll 1
                for (int su = sb; su < 16; su += NSC) skinny_subunit(C, WSP(bf16, WS_MIXED), WSP(bf16, WS_WO), 1024, su >> 2, su & 3, E8); }
              gen += (unsigned)NSC; chain_barrier(C, ctl + 384, gen, bar.bar);
              { const float* MOD = WSP(float, WS_MOD);
#pragma unroll 1
                for (int r = T + sb * NWAVES + C.wave; r < T + NBATCH; r += NSC * NWAVES) { const float* md = MOD + (size_t)(r - T + 1) * 6144;
                    rmsnorm_row<true>(WSP(float, WS_X1) + (size_t)r * 1024, C.in[10], md + 3072, md + 4096, WSP(bf16, WS_H2) + (size_t)r * 1024, C.lane); } }
              gen += (unsigned)NSC; chain_barrier(C, ctl + 384, gen, bar.bar);
              { EpiUp E10{C.ws};
#pragma unroll 1
                for (int su = sb; su < 64; su += NSC) skinny_subunit(C, WSP(bf16, WS_H2), WSP(bf16, WS_WUP), 1024, su >> 2, su & 3, E10); }
              gen += (unsigned)NSC; chain_barrier(C, ctl + 384, gen, bar.bar);
              { EpiResid E11{C.ws, C.in[0], C.in[1], 5120, false};
#pragma unroll 1
                for (int su = sb; su < 16; su += NSC) skinny_subunit(C, WSP(bf16, WS_UP), WSP(bf16, WS_WDN), FF, su >> 2, su & 3, E11); }
              gen += (unsigned)NSC; chain_barrier(C, ctl + 384, gen, bar.bar);
#pragma unroll 1
              for (int r = T + sb * NWAVES + C.wave; r < T + NBATCH; r += NSC * NWAVES)
                  rmsnorm_row<false, true, true>(WSP(float, WS_X2) + (size_t)r * 1024, C.in[11], nullptr, nullptr, C.out + O_YS + (size_t)(r - T) * 1024, C.lane);
              __syncthreads();
          } }
#pragma unroll 1
        for (;;) {
            if (C.tid == 0) MISC[16] = xb_add(ctl + 320, 1u);
            __syncthreads();
            const unsigned qi = MISC[16];
            __syncthreads();
            if (qi >= 512u) break;
            const int qbn = 255 - (int)(qi >> 1);
            nsa_block_task(C, (qi & 1u) ? 511 - qbn : qbn, WSP(bf16, WS_ONSA));
        }
        PHASE_BEGIN();
        ctl = (unsigned*)(C.ws + WS_CTL);
        if (C.tid == 0) { XB_SPIN(xb_ld(ctl + 64) < (unsigned)(C.nb >= 128 ? 64 : C.nb), bar.bar); __builtin_amdgcn_fence(__ATOMIC_ACQUIRE, "agent"); asm volatile("s_waitcnt vmcnt(0)" ::: "memory"); }
        __syncthreads();
#pragma unroll 1
        for (;;) {
            if (C.tid == 0) MISC[16] = xb_add(ctl + 128, 1u);
            __syncthreads();
            const unsigned bt = MISC[16];
            __syncthreads();
            if (bt >= 512u) break;
            ret_out_block(C, (int)bt);
        }
    } SEAM(4);
    if (IN(6)) { PHASE_BEGIN();
        pg8::Gemm g{WSP(bf16, WS_ONSA), WSP(bf16, WS_WBN), T, 1024, 512}; pg8::StaticOrder S; S.init(T, 1024, C.nb, C.bid);
        EpiMixA E{C.ws};
        pg8::gemm_phase<EpiMixA, pg8::StaticOrder, PG8_ALIGN, PG8_SP2>(ring, g, S, E, C.wave);
    }
    if (IN(7)) { PHASE_BEGIN();
        asm volatile("s_waitcnt vmcnt(0)" ::: "memory");
        __syncthreads();
        pg8::Gemm g{WSP(bf16, WS_YRET), WSP(bf16, WS_WBR), T, 1024, 1024}; pg8::StaticOrder S; S.init(T, 1024, C.nb, C.bid);
        EpiMixed E{C.ws};
        pg8::gemm_phase<EpiMixed, pg8::StaticOrder, PG8_ALIGN, PG8_SP2>(ring, g, S, E, C.wave);
    } SEAM(7);
    if (IN(8)) { PHASE_BEGIN();
        pg8::Gemm g{WSP(bf16, WS_MIXED), WSP(bf16, WS_WO), T, 1024, 1024}; pg8::StaticOrder S; S.init(T, 1024, C.nb, C.bid);
        EpiResid E{C.ws, C.in[0], C.in[1], 2048, true};
        pg8::gemm_phase<EpiResid, pg8::StaticOrder, PG8_ALIGN, PG8_SP2>(ring, g, S, E, C.wave);
    } SEAM(8);
    if (IN(9)) { PHASE_BEGIN();
        const float* MOD = WSP(float, WS_MOD);
#pragma unroll 1
        for (int r = 4 * C.gw; r < T; r += 4 * C.ngw)
            rmsnorm_rows4<true, false, false>(WSP(float, WS_X1) + (size_t)r * 1024, 1024, C.in[10], MOD + 3072, MOD + 4096, WSP(bf16, WS_H2) + (size_t)r * 1024, 1024, C.lane);
    } SEAM(9);
    if (IN(10)) { PHASE_BEGIN();
        pg8::Gemm g{WSP(bf16, WS_H2), WSP(bf16, WS_WUP), T, FF, 1024}; pg8::StaticOrder S; S.init(T, FF, C.nb, C.bid);
        EpiUp E{C.ws};
        pg8::gemm_phase<EpiUp, pg8::StaticOrder, PG8_ALIGN, PG8_SP2>(ring, g, S, E, C.wave);
    } SEAM(10);
    if (IN(11)) { PHASE_BEGIN();
        pg8::Gemm g{WSP(bf16, WS_UP), WSP(bf16, WS_WDN), T, 1024, FF}; pg8::StaticOrder S; S.init(T, 1024, C.nb, C.bid);
        EpiResid E{C.ws, C.in[0], C.in[1], 5120, false};
        pg8::gemm_phase<EpiResid, pg8::StaticOrder, PG8_ALIGN, PG8_SP2>(ring, g, S, E, C.wave);
    } SEAM(11);
    if (IN(12)) { PHASE_BEGIN();
#pragma unroll 1
        for (int r = 4 * C.gw; r < T; r += 4 * C.ngw)
            rmsnorm_rows4<false, true, true>(WSP(float, WS_X2) + (size_t)r * 1024, 1024, C.in[11], nullptr, nullptr, C.out + O_Y + (size_t)r * 1024, 1024, C.lane);
    }
#undef IN
#undef SEAM
}

extern "C" void kernel_launch(void* const* d_in, const int* in_sizes, int n_in, void* d_out, int out_size, void* d_ws, size_t ws_size, hipStream_t stream) {
    static int grid = 0;
    if (grid == 0) {
        if (n_in != 24 || (size_t)out_size != O_END || ws_size < WS_END) { fprintf(stderr, "kernel_launch: unexpected shapes (n_in %d, out %d, ws %zu, need %zu)\n", n_in, out_size, ws_size, (size_t)WS_END); grid = -1; return; }
        int dev = 0, cus = 0, per_cu = 0;
        if (hipGetDevice(&dev) != hipSuccess || hipDeviceGetAttribute(&cus, hipDeviceAttributeMultiprocessorCount, dev) != hipSuccess) { grid = -1; return; }
        if (hipFuncSetAttribute((const void*)hybrid_fwd, hipFuncAttributeMaxDynamicSharedMemorySize, LDS_BYTES) != hipSuccess) { fprintf(stderr, "kernel_launch: hipFuncSetAttribute failed\n"); grid = -1; return; }
        if (hipOccupancyMaxActiveBlocksPerMultiprocessor(&per_cu, (const void*)hybrid_fwd, NWAVES * 64, LDS_BYTES) != hipSuccess || per_cu < 1) { fprintf(stderr, "kernel_launch: occupancy query says %d\n", per_cu); per_cu = 1; }
        (void)hipGetLastError();
        grid = cus;
    }
    if (grid < 0) return;
    if (hipMemsetAsync((char*)d_ws + WS_CTL, 0, CTL_BYTES, stream) != hipSuccess) return;
    Args a{};
    for (int i = 0; i < 24; ++i) a.in[i] = (const float*)d_in[i];
    a.out = (float*)d_out; a.ws = (unsigned char*)d_ws;
#if MK_ONE_LAUNCH
    a.ph_lo = 0; a.ph_hi = N_PHASES;
    hipLaunchKernelGGL(hybrid_fwd, dim3(grid), dim3(NWAVES * 64), LDS_BYTES, stream, a);
#else
    for (int p = 0; p < N_PHASES; ++p) { a.ph_lo = p; a.ph_hi = p + 1;
        hipLaunchKernelGGL(hybrid_fwd, dim3(grid), dim3(NWAVES * 64), LDS_BYTES, stream, a); }
#endif
}
```

```cpp
#include <hip/hip_runtime.h>
#include <cstdio>
#include <cstdint>
namespace pg8 {
#define PG8_LAS __attribute__((address_space(3)))
typedef unsigned short bf16_t;
typedef short bf16x8 __attribute__((ext_vector_type(8)));
typedef float f32x4 __attribute__((ext_vector_type(4)));
typedef unsigned u32x4 __attribute__((ext_vector_type(4)));
constexpr int BM = 256, BK = 64, HALF = 128, HTB = HALF * BK * 2  , STAGE_BYTES = 8 * HTB, NXCD = 8, WGM = 8;

__host__ __device__ __forceinline__ int lds_byte(int r, int c) { const int st = (r >> 4) * 2 + (c >> 5), rr = r & 15, cc = c & 31, ob = rr * 64 + cc * 2; return st * 1024 + (ob ^ (((ob >> 9) & 1) << 5)); }
__host__ __device__ __forceinline__ void stage_rc(int b, int& R, int& C) { const int st = b / 1024, sb = b % 1024, swz = sb ^ (((sb >> 9) & 1) << 5); R = (st >> 1) * 16 + swz / 64; C = (st & 1) * 32 + (swz % 64) / 2; }
__host__ __device__ __forceinline__ int perm32(int rho) { const int n = rho >> 4, i = rho & 15; return 8 * (i >> 2) + 4 * n + (i & 3); }

struct Unit { int pm, pn; };
struct Gemm { const bf16_t* A; const bf16_t* Bt; int M, N, K; };

struct StaticOrder {
    int nM, nN, nwg, G, c;
    __host__ __device__ void init(int M, int N, int G_, int c_) { nM = M / BM; nN = N / BM; nwg = nM * nN; G = G_; c = c_; }
    __host__ __device__ bool next(int i, Unit& u) const {
        const long L = (long)i * G + c; if (L >= nwg) return false;
        int wgid = (int)L; { const int q = nwg / NXCD, r = nwg % NXCD, xcd = wgid % NXCD, off = wgid / NXCD; wgid = (xcd < r ? xcd * (q + 1) : r * (q + 1) + (xcd - r) * q) + off; }
        const int nig = WGM * nN, gid = wgid / nig, fm = gid * WGM, gsz = (nM - fm) < WGM ? (nM - fm) : WGM;
        u.pm = fm + ((wgid % nig) % gsz); u.pn = (wgid % nig) / gsz; return true;
    }
    __device__ __forceinline__ void a_ready(const Unit&) const {}
    __device__ __forceinline__ void done(const Unit&) const {}
};

__device__ __forceinline__ unsigned cvt_pk_bf16(float lo, float hi) { unsigned r; asm volatile("v_cvt_pk_bf16_f32 %0, %1, %2" : "=v"(r) : "v"(lo), "v"(hi)); return r; }
typedef float f32x2 __attribute__((ext_vector_type(2)));
template <class Epi, class Sched, bool ALIGN_EPI = false, bool SP2 = false>
__device__ __forceinline__ void gemm_phase(PG8_LAS unsigned char* lds, const Gemm g, const Sched& S, const Epi& E, const int wid) {
    int lane; asm volatile("v_mbcnt_lo_u32_b32 %0, -1, 0\n\tv_mbcnt_hi_u32_b32 %0, -1, %0" : "=v"(lane));
    const int tid = wid * 64 + lane, wr = wid >> 2, wc = wid & 3, fr = lane & 15, fq = lane >> 4;
    const int K = g.K, nt = K / BK;
    unsigned voffA[2], voffB[2];
#pragma unroll
    for (int i = 0; i < 2; ++i) { int R, C; stage_rc(tid * 16 + i * 8192, R, C); const int Rb = Epi::PERM ? ((R & ~31) + perm32(R & 31)) : R;
        voffA[i] = (unsigned)(R * K + C) * 2u; voffB[i] = (unsigned)(Rb * K + C) * 2u; }
    const size_t kstep = (size_t)(BK * 2);
    const size_t hstep = (size_t)HALF * K * 2;
    const size_t tstep = 2 * hstep;
    const unsigned ldsw = (unsigned)wid * 1024u;
    const int aoff = lds_byte(wr * 64 + fr, fq * 8), boff = lds_byte(wc * 32 + fr, fq * 8);
#define PG8_SA(b, h) (((b) * 2 + (h)) * HTB)
#define PG8_SB(b, h) ((4 + (b) * 2 + (h)) * HTB)
#define PG8_STAGE(bufoff, gbase, voff) do { _Pragma("unroll") for (int _i = 0; _i < 2; ++_i) \
        __builtin_amdgcn_global_load_lds((const unsigned*)((const char*)(gbase) + (voff)[_i]), (PG8_LAS unsigned*)(lds + (bufoff) + ldsw + _i * 8192), 16, 0, 0); } while (0)
#define PG8_LDA(dst, b, h) do { _Pragma("unroll") for (int m = 0; m < 4; ++m) _Pragma("unroll") for (int k = 0; k < 2; ++k) dst[m][k] = *(const PG8_LAS bf16x8*)(lds + PG8_SA(b, h) + aoff + m * 2048 + k * 1024); } while (0)
#define PG8_LDB(dst, b, h) do { _Pragma("unroll") for (int n = 0; n < 2; ++n) _Pragma("unroll") for (int k = 0; k < 2; ++k) dst[n][k] = *(const PG8_LAS bf16x8*)(lds + PG8_SB(b, h) + boff + n * 2048 + k * 1024); } while (0)
#define PG8_MMA(ai, bj, At, Bt) do { __builtin_amdgcn_s_setprio(1); _Pragma("unroll") for (int m = 0; m < 4; ++m) _Pragma("unroll") for (int n = 0; n < 2; ++n) _Pragma("unroll") for (int k = 0; k < 2; ++k) \
        acc[ai][bj][m][n] = __builtin_amdgcn_mfma_f32_16x16x32_bf16(Bt[n][k], At[m][k], acc[ai][bj][m][n], 0, 0, 0); __builtin_amdgcn_s_setprio(0); } while (0)
#define PG8_WAIT_V(n) asm volatile("s_waitcnt vmcnt(" #n ")" ::: "memory")
#define PG8_WAIT_L(n) asm volatile("s_waitcnt lgkmcnt(" #n ")" ::: "memory")
#define PG8_BAR __builtin_amdgcn_s_barrier()
#define PG8_SCHED __builtin_amdgcn_sched_barrier(0)
    Unit cur, nxt; int ui = 0;
    if (!S.next(0, cur)) return;
    f32x4 acc[2][2][4][2];
#pragma unroll
    for (int a = 0; a < 2; ++a)
#pragma unroll
        for (int b = 0; b < 2; ++b)
#pragma unroll
            for (int m = 0; m < 4; ++m)
#pragma unroll
                for (int n = 0; n < 2; ++n) acc[a][b][m][n] = (f32x4){0.f, 0.f, 0.f, 0.f};
    bf16x8 At[4][2], B0[2][2], B1[2][2];
    const char* cA = (const char*)g.A + (size_t)cur.pm * tstep; const char* cB = (const char*)g.Bt + (size_t)cur.pn * tstep;
    S.a_ready(cur);
    if constexpr (SP2) {
        PG8_STAGE(PG8_SB(0, 0), cB, voffB); PG8_STAGE(PG8_SB(0, 1), cB + hstep, voffB); PG8_STAGE(PG8_SA(0, 0), cA, voffA); PG8_STAGE(PG8_SA(0, 1), cA + hstep, voffA);
        if (wr == 1) PG8_BAR;
        PG8_WAIT_V(2); PG8_BAR;
        PG8_STAGE(PG8_SB(1, 0), cB + kstep, voffB); PG8_STAGE(PG8_SA(1, 0), cA + kstep, voffA); PG8_STAGE(PG8_SB(1, 1), cB + hstep + kstep, voffB);
        PG8_WAIT_V(6); PG8_BAR;
    } else {
        PG8_STAGE(PG8_SB(0, 0), cB, voffB); PG8_STAGE(PG8_SA(0, 0), cA, voffA); PG8_STAGE(PG8_SB(0, 1), cB + hstep, voffB); PG8_STAGE(PG8_SA(0, 1), cA + hstep, voffA);
        if (wr == 1) PG8_BAR;
        PG8_WAIT_V(4); PG8_BAR;
        PG8_STAGE(PG8_SB(1, 0), cB + kstep, voffB); PG8_STAGE(PG8_SA(1, 0), cA + kstep, voffA); PG8_STAGE(PG8_SB(1, 1), cB + hstep + kstep, voffB);
        PG8_WAIT_V(6); PG8_BAR;
    }
    for (;;) {
        const bool has_next = S.next(ui + 1, nxt);
        const char* nA = has_next ? (const char*)g.A + (size_t)nxt.pm * tstep : cA; const char* nB = has_next ? (const char*)g.Bt + (size_t)nxt.pn * tstep : cB;
        for (int t = 0; t < nt; t += 2) {
            const bool last = (t == nt - 2);
            const char* a1 = cA + (size_t)(t + 1) * kstep;
            const char* a2 = last ? nA : cA + (size_t)(t + 2) * kstep; const char* b2 = last ? nB : cB + (size_t)(t + 2) * kstep;
            const char* a3 = a2 + kstep; const char* b3 = b2 + kstep;
            if (last && has_next) S.a_ready(nxt);
            if constexpr (SP2) {
            PG8_LDB(B0, 0, 0); PG8_LDB(B1, 0, 1); PG8_SCHED; PG8_LDA(At, 0, 0); PG8_STAGE(PG8_SA(1, 1), a1 + hstep, voffA);
            PG8_WAIT_V(8); PG8_WAIT_L(0); PG8_BAR; PG8_MMA(0, 0, At, B0); PG8_MMA(0, 1, At, B1); PG8_BAR; PG8_SCHED;
            PG8_LDA(At, 0, 1); PG8_STAGE(PG8_SB(0, 0), b2, voffB); PG8_STAGE(PG8_SB(0, 1), b2 + hstep, voffB); PG8_STAGE(PG8_SA(0, 0), a2, voffA);
            PG8_WAIT_V(8); PG8_WAIT_L(0); PG8_BAR; PG8_MMA(1, 0, At, B0); PG8_MMA(1, 1, At, B1); PG8_BAR; PG8_SCHED;
            PG8_LDB(B0, 1, 0); PG8_LDB(B1, 1, 1); PG8_SCHED; PG8_LDA(At, 1, 0); PG8_STAGE(PG8_SA(0, 1), a2 + hstep, voffA);
            PG8_WAIT_V(8); PG8_WAIT_L(0); PG8_BAR; PG8_MMA(0, 0, At, B0); PG8_MMA(0, 1, At, B1); PG8_BAR; PG8_SCHED;
            PG8_LDA(At, 1, 1); PG8_STAGE(PG8_SB(1, 0), b3, voffB); PG8_STAGE(PG8_SB(1, 1), b3 + hstep, voffB); PG8_STAGE(PG8_SA(1, 0), a3, voffA);
            PG8_WAIT_V(8); PG8_WAIT_L(0); PG8_BAR; PG8_MMA(1, 0, At, B0); PG8_MMA(1, 1, At, B1); PG8_BAR; PG8_SCHED;
            } else {
            PG8_LDB(B0, 0, 0); PG8_SCHED; PG8_LDA(At, 0, 0); PG8_STAGE(PG8_SA(1, 1), a1 + hstep, voffA);
            PG8_WAIT_L(8); PG8_BAR; PG8_WAIT_L(0); PG8_MMA(0, 0, At, B0); PG8_BAR; PG8_SCHED;
            PG8_LDB(B1, 0, 1); PG8_STAGE(PG8_SB(0, 0), b2, voffB);
            PG8_BAR; PG8_WAIT_L(0); PG8_MMA(0, 1, At, B1); PG8_BAR;
            PG8_LDA(At, 0, 1); PG8_STAGE(PG8_SA(0, 0), a2, voffA);
            PG8_BAR; PG8_WAIT_L(0); PG8_MMA(1, 0, At, B0); PG8_BAR; PG8_SCHED;
            PG8_STAGE(PG8_SB(0, 1), b2 + hstep, voffB);
            PG8_WAIT_V(6); PG8_BAR; PG8_MMA(1, 1, At, B1); PG8_BAR;
            PG8_LDB(B0, 1, 0); PG8_SCHED; PG8_LDA(At, 1, 0); PG8_STAGE(PG8_SA(0, 1), a2 + hstep, voffA);
            PG8_WAIT_L(8); PG8_BAR; PG8_WAIT_L(0); PG8_MMA(0, 0, At, B0); PG8_BAR; PG8_SCHED;
            PG8_LDB(B1, 1, 1); PG8_STAGE(PG8_SB(1, 0), b3, voffB);
            PG8_BAR; PG8_WAIT_L(0); PG8_MMA(0, 1, At, B1); PG8_BAR;
            PG8_LDA(At, 1, 1); PG8_STAGE(PG8_SA(1, 0), a3, voffA);
            PG8_BAR; PG8_WAIT_L(0); PG8_MMA(1, 0, At, B0); PG8_BAR; PG8_SCHED;
            PG8_STAGE(PG8_SB(1, 1), b3 + hstep, voffB);
            PG8_WAIT_V(6); PG8_BAR; PG8_MMA(1, 1, At, B1); PG8_BAR;
            }
        }
        if constexpr (ALIGN_EPI) { if (wr == 0) PG8_BAR; }
        if constexpr (!Epi::AFTER_DRAIN) { E(acc, cur, wr, wc, fr, fq); S.done(cur); }
        if (!has_next) break;
#pragma unroll
        for (int a = 0; a < 2; ++a)
#pragma unroll
            for (int b = 0; b < 2; ++b)
#pragma unroll
                for (int m = 0; m < 4; ++m)
#pragma unroll
                    for (int n = 0; n < 2; ++n) acc[a][b][m][n] = (f32x4){0.f, 0.f, 0.f, 0.f};
        cur = nxt; cA = nA; cB = nB; ++ui;
        if constexpr (ALIGN_EPI) { if (wr == 1) PG8_BAR; }
    }
    PG8_WAIT_V(0);
    if constexpr (!ALIGN_EPI) { if (wr == 0) PG8_BAR; }
    PG8_BAR;
    if constexpr (Epi::AFTER_DRAIN) { E.fused(acc, cur, wr, wc, fr, fq, lds, wid, lane); S.done(cur); }
#undef PG8_SA
#undef PG8_SB
#undef PG8_STAGE
#undef PG8_LDA
#undef PG8_LDB
#undef PG8_MMA
#undef PG8_WAIT_V
#undef PG8_WAIT_L
#undef PG8_BAR
#undef PG8_SCHED
}
}

#define PG8_SP2 true
#define PG8_ALIGN true
#define GAS __attribute__((address_space(1)))
#define LAS __attribute__((address_space(3)))
typedef unsigned short bf16;
typedef unsigned v4u __attribute__((ext_vector_type(4)));
typedef unsigned v2u __attribute__((ext_vector_type(2)));
typedef float f32x4 __attribute__((ext_vector_type(4)));
typedef short bf16x8 __attribute__((ext_vector_type(8)));
typedef GAS unsigned gu32;
#define RLX_AGENT __ATOMIC_RELAXED, __HIP_MEMORY_SCOPE_AGENT
#define LDS_WAIT() asm volatile("s_waitcnt lgkmcnt(0)" ::: "memory")
#define VM_WAIT() asm volatile("s_waitcnt vmcnt(0)" ::: "memory")
__device__ __forceinline__ unsigned f2bf(float f) { unsigned u = __builtin_bit_cast(unsigned, f); return (u + 0x7fffu + ((u >> 16) & 1u)) >> 16; }
__device__ __forceinline__ unsigned pk2(float lo, float hi) { return f2bf(lo) | (f2bf(hi) << 16); }
__device__ __forceinline__ float bf2f(unsigned short b) { return __builtin_bit_cast(float, (unsigned)b << 16); }

constexpr int NWAVES = 8;
constexpr int T = 16384, DM = 1024, NBATCH = 32, MROWS = 16640, RP = MROWS, FF = 4096;
constexpr int LIN = 6424, NIN = 6656;
constexpr int N_PHASES = 13;
#ifndef MK_ONE_LAUNCH
#define MK_ONE_LAUNCH 1
#endif
constexpr size_t O_Y = 0, O_YS = 16777216, O_CMPP = 16809984, O_SELP = 21004288, O_WINP = 25198592, O_STP = 25329664,
                 O_CMPS = 25460736, O_SELS = 25468928, O_WINS = 25477120, O_STS = 29671424, O_END = 33865728;
constexpr size_t al256(size_t x) { return (x + 255) & ~(size_t)255; }
constexpr size_t WS_CTL = 0, CTL_BYTES = (size_t)1 << 20;
constexpr size_t WS_WIN  = CTL_BYTES;
constexpr size_t WS_WBN  = WS_WIN  + al256((size_t)NIN * 1024 * 2);
constexpr size_t WS_WBR  = WS_WBN  + al256((size_t)1024 * 512 * 2);
constexpr size_t WS_WO   = WS_WBR  + al256((size_t)1024 * 1024 * 2);
constexpr size_t WS_WUP  = WS_WO   + al256((size_t)1024 * 1024 * 2);
constexpr size_t WS_WDN  = WS_WUP  + al256((size_t)4096 * 1024 * 2);
constexpr size_t WS_MOD  = WS_WDN  + al256((size_t)4096 * 1024 * 2);
constexpr size_t WS_COS64 = WS_MOD + al256((size_t)33 * 6144 * 4);
constexpr size_t WS_SIN64 = WS_COS64 + al256((size_t)16385 * 32 * 4);
constexpr size_t WS_COS128 = WS_SIN64 + al256((size_t)16385 * 32 * 4);
constexpr size_t WS_SIN128 = WS_COS128 + al256((size_t)16385 * 64 * 4);
constexpr size_t WS_GPOW = WS_SIN128 + al256((size_t)16385 * 64 * 4);
constexpr size_t WS_GINV = WS_GPOW + al256(4 * 132 * 4);
constexpr size_t WS_ST64 = WS_GINV + al256(4 * 132 * 4);
constexpr size_t WS_ST128 = WS_ST64 + 256;
constexpr size_t WS_H    = WS_ST128 + 512;
constexpr size_t WS_Q    = WS_H    + al256((size_t)MROWS * 1024 * 2);
constexpr size_t WS_KS   = WS_Q    + al256((size_t)MROWS * 512 * 2);
constexpr size_t WS_VST  = WS_KS   + al256((size_t)2 * RP * 64 * 2);
constexpr size_t WS_KW   = WS_VST  + al256((size_t)2 * RP * 64 * 2);
constexpr size_t WS_VWT  = WS_KW   + al256((size_t)2 * RP * 64 * 2);
constexpr size_t WS_GN   = WS_VWT  + al256((size_t)2 * RP * 64 * 2);
constexpr size_t WS_RQD  = WS_GN   + al256((size_t)MROWS * 24 * 4);
constexpr size_t WS_RKI  = WS_RQD  + al256((size_t)MROWS * 512 * 2);
constexpr size_t WS_RKIT = WS_RKI  + al256((size_t)MROWS * 512 * 2);
constexpr size_t WS_RVT  = WS_RKIT + al256((size_t)MROWS * 512 * 2);
constexpr size_t WS_SRG  = WS_RVT  + al256((size_t)MROWS * 1024 * 2);
constexpr size_t WS_SGA  = WS_SRG  + al256((size_t)MROWS * 1024 * 2);
constexpr size_t WS_SGB  = WS_SGA  + al256((size_t)MROWS * 1024 * 2);
constexpr size_t WS_CMPKP = WS_SGB + al256((size_t)MROWS * 1024 * 2);
constexpr size_t WS_CMPVP = WS_CMPKP + al256((size_t)2 * 1024 * 64 * 2);
constexpr size_t WS_CMPKS = WS_CMPVP + al256((size_t)2 * 1024 * 64 * 2);
constexpr size_t WS_CMPVS = WS_CMPKS + al256((size_t)64 * 1024 * 64 * 2);
constexpr size_t WS_U    = WS_CMPVS + al256((size_t)64 * 1024 * 64 * 2);
constexpr size_t WS_SPREV = WS_U   + al256((size_t)128 * 131072 * 4);
constexpr size_t WS_ONSA = WS_SPREV + al256((size_t)128 * 131072 * 2);
constexpr size_t WS_YRET = WS_ONSA + al256((size_t)MROWS * 512 * 2);
constexpr size_t WS_MIXA = WS_YRET + al256((size_t)MROWS * 1024 * 2);
constexpr size_t WS_MIXED = WS_MIXA + al256((size_t)MROWS * 1024 * 4);
constexpr size_t WS_X1   = WS_MIXED + al256((size_t)MROWS * 1024 * 2);
constexpr size_t WS_UP   = WS_X1   + al256((size_t)MROWS * 1024 * 4);
constexpr size_t WS_H2   = WS_UP   + al256((size_t)MROWS * 4096 * 2);
constexpr size_t WS_X2   = WS_H2   + al256((size_t)MROWS * 1024 * 2);
constexpr size_t WS_STASH = WS_X2  + al256((size_t)MROWS * 1024 * 4);
constexpr size_t WS_END  = WS_STASH + al256((size_t)2048 * 512 * 16);
constexpr int CW_BAR = 4096;
constexpr int RING_BYTES = 131072, MISC_OFF = 143360, LDS_BYTES = 147456;

constexpr float QSCALE = 0.125f * 1.4426950408889634f;
constexpr float RK_SCALE = 0.08838834764831845f;

typedef pg8::f32x4 f4;
__device__ __forceinline__ unsigned cvtpk(float lo, float hi) { unsigned r; asm("v_cvt_pk_bf16_f32 %0, %1, %2" : "=v"(r) : "v"(lo), "v"(hi)); return r; }
__device__ __forceinline__ v4u pack8u(const f4& a, const f4& b) { v4u w; w.x = cvtpk(a[0], a[1]); w.y = cvtpk(a[2], a[3]); w.z = cvtpk(b[0], b[1]); w.w = cvtpk(b[2], b[3]); return w; }
__device__ __forceinline__ bf16x8 pack8(const f4& a, const f4& b) { return __builtin_bit_cast(bf16x8, pack8u(a, b)); }
__device__ __forceinline__ unsigned short bf1(float x) { return (unsigned short)(cvtpk(x, x) & 0xffffu); }
__device__ __forceinline__ float fexp2(float x) { return __builtin_amdgcn_exp2f(x); }
__device__ __forceinline__ int lane_id() { int x; asm volatile("v_mbcnt_lo_u32_b32 %0, -1, 0\n\tv_mbcnt_hi_u32_b32 %0, -1, %0" : "=v"(x)); return x; }
__device__ __forceinline__ int launder_v(int x) { asm volatile("" : "+v"(x)); return x; }
template <class P> __device__ __forceinline__ P* launder_p(P* p) { unsigned long long v = (unsigned long long)p; asm volatile("" : "+s"(v)); return (P*)v; }
__device__ __forceinline__ int launder_s(int x) { x = __builtin_amdgcn_readfirstlane(x); asm volatile("" : "+s"(x)); return x; }
__device__ __forceinline__ float sigmoidf_(float x) { return __builtin_amdgcn_rcpf(1.0f + __expf(-x)); }
__device__ __forceinline__ float wave_sum(float v) {
#pragma unroll
    for (int o = 1; o < 64; o <<= 1) v += __shfl_xor(v, o);
    return v;
}
#define MFMA16(a, b, c) __builtin_amdgcn_mfma_f32_16x16x32_bf16((a), (b), (c), 0, 0, 0)
#define WAVE_SYNC() do { __builtin_amdgcn_wave_barrier(); asm volatile("s_waitcnt lgkmcnt(0)" ::: "memory"); __builtin_amdgcn_wave_barrier(); } while (0)

struct Ctx {
    LAS unsigned char* lds;
    int tid, lane, wave, bid, nb, gw, ngw;
    const float* in[24]; float* out; unsigned char* ws;
};
#define WSP(type, off) ((type*)(C.ws + (off)))

__device__ __forceinline__ void transpose_item(const float* W, int K, int N, bf16* WT, int kb, int src_col0, int ncols, int dst_row0, LAS float* scr, int lane) {
    const int k0 = 64 * kb;
    float tv[32];
#pragma unroll
    for (int i = 0; i < 32; ++i) { const int kk = 2 * i + (lane >> 5); const int cn = lane & 31;
        tv[i] = (cn < ncols) ? __builtin_nontemporal_load(W + (size_t)(k0 + kk) * N + src_col0 + cn) : 0.f; }
#pragma unroll
    for (int i = 0; i < 32; ++i) { const int kk = 2 * i + (lane >> 5); const int cn = lane & 31; scr[kk * 33 + cn] = tv[i]; }
    WAVE_SYNC();
    const int c = lane & 7;
#pragma unroll
    for (int j = 0; j < 4; ++j) { const int n = (lane >> 3) + 8 * j; const LAS float* s = scr + (8 * c) * 33 + n;
        v4u o; o.x = pk2(s[0 * 33], s[1 * 33]); o.y = pk2(s[2 * 33], s[3 * 33]); o.z = pk2(s[4 * 33], s[5 * 33]); o.w = pk2(s[6 * 33], s[7 * 33]);
        *(GAS v4u*)(WT + (size_t)(dst_row0 + n) * K + k0 + 8 * c) = o; }
    WAVE_SYNC();
}
__device__ __forceinline__ int win_src_col(int pb, int& ncols) {
    const int tile = pb >> 3, blk = pb & 7, bj = blk >> 2, wcb = blk & 3; ncols = 32;
    if (tile < 2)  return 256 * tile + 64 * wcb + 32 * bj;
    if (tile < 5)  return 512 + 256 * (tile - 2) + 64 * wcb + 32 * bj;
    if (tile < 7)  return 1304 + 256 * (tile - 5) + 128 * (wcb >> 1) + 64 * bj + 32 * (wcb & 1);
    if (tile < 9)  return 1816 + 256 * (tile - 7) + 128 * (wcb >> 1) + 64 * bj + 32 * (wcb & 1);
    if (tile < 13) return 2328 + 256 * (tile - 9) + 32 * blk;
    if (tile < 17) return 3352 + 256 * (tile - 13) + 32 * blk;
    if (tile < 21) return 4376 + 256 * (tile - 17) + 32 * blk;
    if (tile < 25) return 5400 + 256 * (tile - 21) + 32 * blk;
    if (blk == 0) { ncols = 24; return 1280; }
    ncols = 0; return 0;
}

__device__ __forceinline__ void cmp_build_page(const float* base0, const float* base1, const LAS float* wl, const float* b_cmp, bf16* Kd, bf16* VTd, int p, int lane) {
    const int ch = 4 * lane, c = ch >> 7, h = (ch >> 6) & 1, d = ch & 63;
    const LAS float* wp = wl + ((c * 2 + h) * 32) * 64 + d;
    const f4 bias = *(const f4*)(b_cmp + (c * 2 + h) * 64 + d);
    f4 acc[8];
#pragma unroll
    for (int n = 0; n < 8; ++n) acc[n] = bias;
    const int nstr = base1 ? 9 : 8;
#pragma unroll
    for (int n = 0; n < 9; ++n) {
        if (n < nstr) {
            const float* rb = (n < 8) ? base0 + (size_t)(16 * n) * 256 + ch : base1 + ch;
            f4 x[16];
#pragma unroll
            for (int jj = 0; jj < 16; ++jj) x[jj] = __builtin_nontemporal_load((const f4*)(rb + (size_t)jj * 256));
#pragma unroll
            for (int jj = 0; jj < 16; ++jj) {
                if (n < 8) acc[n < 8 ? n : 0] += *(const LAS f4*)(wp + jj * 64) * x[jj];
                if (n > 0) acc[n > 0 ? n - 1 : 0] += *(const LAS f4*)(wp + (16 + jj) * 64) * x[jj];
            }
        }
    }
    if (!base1) acc[7] = (f4){0.f, 0.f, 0.f, 0.f};
    if (c == 0) {
#pragma unroll
        for (int n = 0; n < 8; ++n) { v2u w; w.x = cvtpk(acc[n][0], acc[n][1]); w.y = cvtpk(acc[n][2], acc[n][3]); *(v2u*)(Kd + ((size_t)h * 1024 + 8 * p + n) * 64 + d) = w; }
    } else {
#pragma unroll
        for (int q = 0; q < 4; ++q) { v4u w; w.x = cvtpk(acc[0][q], acc[1][q]); w.y = cvtpk(acc[2][q], acc[3][q]); w.z = cvtpk(acc[4][q], acc[5][q]); w.w = cvtpk(acc[6][q], acc[7][q]);
            *(v4u*)(VTd + ((size_t)h * 64 + d + q) * 1024 + 8 * p) = w; }
    }
}
__device__ __forceinline__ void stage_wcmp(Ctx& C) {
    LAS f4* wl = (LAS f4*)C.lds; const f4* src = (const f4*)C.in[15];
    __syncthreads();
    { f4 t[4];
#pragma unroll
      for (int i = 0; i < 4; ++i) t[i] = src[C.tid + 512 * i];
#pragma unroll
      for (int i = 0; i < 4; ++i) wl[C.tid + 512 * i] = t[i]; }
    __syncthreads();
}

__device__ __forceinline__ double gamma_h(int h) { return 1.0 - exp2(-5.0 - (double)h); }

__device__ __forceinline__ void phase0(Ctx& C, int mask) {
    const float* c_prompt = C.in[2]; const float* c_sample = C.in[3];
    const float* w_ada = C.in[12]; const float* b_ada = C.in[13];
    float* MOD = WSP(float, WS_MOD);
    if (mask & 1) {
        LAS float* sil = (LAS float*)(C.lds + C.wave * 16384);
        LAS float* red = (LAS float*)(C.lds);
        for (int task = C.bid; task < 192; task += C.nb) {
            const int col = 32 * task + (C.lane & 31), kh = C.lane >> 5;
#pragma unroll 1
            for (int half = 0; half < 2; ++half) {
                const int r0 = half * 17, nr = half ? 16 : 17;
#pragma unroll 1
                for (int i0 = 0; i0 < 34; i0 += 17) {
                    float cvv[17];
#pragma unroll
                    for (int i = 0; i < 17; ++i) { const int e = C.lane + 64 * (i0 + i), rr = e >> 7, kk = e & 127, r = r0 + rr, k = 128 * C.wave + kk;
                        cvv[i] = (e < nr * 128) ? ((r == 0) ? c_prompt[k] : c_sample[(size_t)(r - 1) * 1024 + k]) : 0.f; }
#pragma unroll
                    for (int i = 0; i < 17; ++i) { const int e = C.lane + 64 * (i0 + i); if (e < nr * 128) sil[e] = cvv[i] * sigmoidf_(cvv[i]); } }
                WAVE_SYNC();
                float acc[17];
#pragma unroll
                for (int r = 0; r < 17; ++r) acc[r] = 0.f;
#pragma unroll 8
                for (int k4 = 0; k4 < 16; ++k4) { const int kl = 64 * kh + 4 * k4; float wv[4];
#pragma unroll
                    for (int q = 0; q < 4; ++q) wv[q] = __builtin_nontemporal_load(w_ada + (size_t)(128 * C.wave + kl + q) * 6144 + col);
#pragma unroll
                    for (int r = 0; r < 17; ++r) { const f4 s4 = *(const LAS f4*)(sil + r * 128 + kl); acc[r] += (s4[0] * wv[0] + s4[1] * wv[1]) + (s4[2] * wv[2] + s4[3] * wv[3]); } }
#pragma unroll
                for (int r = 0; r < 17; ++r) acc[r] += __shfl_xor(acc[r], 32);
                __syncthreads();
                if (C.lane < 32) {
#pragma unroll
                    for (int r = 0; r < 17; ++r) red[(C.wave * 17 + r) * 32 + C.lane] = acc[r];
                }
                __syncthreads();
                for (int e = C.tid; e < nr * 32; e += 512) { const int rr = e >> 5, cc = e & 31; float s = 0.f;
#pragma unroll
                    for (int w = 0; w < 8; ++w) s += red[(w * 17 + rr) * 32 + cc];
                    MOD[(size_t)(r0 + rr) * 6144 + 32 * task + cc] = s + b_ada[32 * task + cc]; }
                __syncthreads();
            }
        }
    }
    if (mask & 2) {
        LAS float* scr = (LAS float*)(C.lds + C.wave * 16384);
        constexpr int I_IN = 16 * 208, I_BN = 8 * 32, I_BR = 16 * 32, I_O = 16 * 32, I_UP = 16 * 128, I_DN = 64 * 32;
        constexpr int NIT = I_IN + I_BN + I_BR + I_O + I_UP + I_DN;
        for (int it = C.gw; it < NIT; it += C.ngw) {
            int r = it;
            if (r < I_IN) { const int kb = r / 208, pb = r % 208; int nc; const int sc = win_src_col(pb, nc);
                transpose_item(C.in[14], 1024, LIN, WSP(bf16, WS_WIN), kb, sc, nc, 32 * pb, scr, C.lane); continue; } r -= I_IN;
            if (r < I_BN) { transpose_item(C.in[19], 512, 1024, WSP(bf16, WS_WBN), r / 32, 32 * (r % 32), 32, 32 * (r % 32), scr, C.lane); continue; } r -= I_BN;
            if (r < I_BR) { transpose_item(C.in[20], 1024, 1024, WSP(bf16, WS_WBR), r / 32, 32 * (r % 32), 32, 32 * (r % 32), scr, C.lane); continue; } r -= I_BR;
            if (r < I_O)  { transpose_item(C.in[21], 1024, 1024, WSP(bf16, WS_WO), r / 32, 32 * (r % 32), 32, 32 * (r % 32), scr, C.lane); continue; } r -= I_O;
            if (r < I_UP) { transpose_item(C.in[22], 1024, 4096, WSP(bf16, WS_WUP), r / 128, 32 * (r % 128), 32, 32 * (r % 128), scr, C.lane); continue; } r -= I_UP;
            transpose_item(C.in[23], 4096, 1024, WSP(bf16, WS_WDN), r / 32, 32 * (r % 32), 32, 32 * (r % 32), scr, C.lane);
        }
    }
    if (mask & 4) {
        const int gt = C.bid * 512 + C.tid, ngt = C.nb * 512;
        float* c64 = WSP(float, WS_COS64); float* s64 = WSP(float, WS_SIN64); float* c128 = WSP(float, WS_COS128); float* s128 = WSP(float, WS_SIN128);
        constexpr double TWO_PI = 6.283185307179586476925, INV_2PI = 0.15915494309189533577;
        { const float inv = (float)pow(10000.0, -(double)(2 * (gt & 31)) / 64.0);
          for (int e = gt; e < 16385 * 32; e += ngt) { const int pos = e >> 5; const float ang = (float)pos * inv;
            const double q = rint((double)ang * INV_2PI); const float r = (float)fma(-q, TWO_PI, (double)ang);
            c64[e] = cosf(r); s64[e] = sinf(r); } }
        { const float inv = (float)pow(10000.0, -(double)(2 * (gt & 63)) / 128.0);
          for (int e = gt; e < 16385 * 64; e += ngt) { const int pos = e >> 6; const float ang = (float)pos * inv;
            const double q = rint((double)ang * INV_2PI); const float r = (float)fma(-q, TWO_PI, (double)ang);
            c128[e] = cosf(r); s128[e] = sinf(r); } }
        { float* st64 = WSP(float, WS_ST64); float* st128 = WSP(float, WS_ST128);
          for (int e = gt; e < 32; e += ngt) { const float inv = (float)pow(10000.0, -(double)(2 * e) / 64.0); st64[e] = (float)cos(16.0 * (double)inv); st64[32 + e] = (float)sin(16.0 * (double)inv); }
          for (int e = gt; e < 64; e += ngt) { const float inv = (float)pow(10000.0, -(double)(2 * e) / 128.0); st128[e] = (float)cos(16.0 * (double)inv); st128[64 + e] = (float)sin(16.0 * (double)inv); } }
        float* gp = WSP(float, WS_GPOW); float* gi = WSP(float, WS_GINV);
        for (int e = gt; e < 4 * 132; e += ngt) { const int h = e / 132, n = e % 132; const double lg = log(gamma_h(h));
            gp[e] = (float)exp((double)n * lg); gi[e] = (float)exp(-(double)n * lg); }
        unsigned* hz = (unsigned*)(WSP(bf16, WS_H) + (size_t)(T + NBATCH) * 1024);
        for (int e = gt; e < (MROWS - T - NBATCH) * 512; e += ngt) hz[e] = 0u;
    }
    if (mask & 8) {
        const float* cw = C.in[6];
#pragma unroll 1
        for (int rr0 = C.gw; rr0 < NBATCH * 511; rr0 += 8 * C.ngw) { f4 v[8];
#pragma unroll
            for (int q = 0; q < 8; ++q) { const int rr = rr0 + q * C.ngw; const int b = rr / 511, j = rr % 511;
                if (rr < NBATCH * 511) v[q] = __builtin_nontemporal_load((const f4*)(cw + ((size_t)b * 512 + j + 1) * 256) + C.lane); }
#pragma unroll
            for (int q = 0; q < 8; ++q) { const int rr = rr0 + q * C.ngw; const int b = rr / 511, j = rr % 511;
                if (rr < NBATCH * 511) *((f4*)(C.out + O_WINS + ((size_t)b * 512 + j) * 256) + C.lane) = v[q]; } }
    }
    if (mask & 16) {
        const float* cc = C.in[4]; const int* pt = (const int*)C.in[8];
        stage_wcmp(C);
        for (int task = C.gw; task < NBATCH * 128; task += C.ngw) { const int b = task >> 7, p = task & 127;
            const int ph0 = pt[b * 128 + p]; const int ph1 = (p < 127) ? pt[b * 128 + p + 1] : 0;
            const float* base0 = cc + (size_t)ph0 * 128 * 256; const float* base1 = (p < 127) ? cc + (size_t)ph1 * 128 * 256 : nullptr;
            cmp_build_page(base0, base1, (const LAS float*)C.lds, C.in[16], WSP(bf16, WS_CMPKS) + (size_t)b * 2 * 65536, WSP(bf16, WS_CMPVS) + (size_t)b * 2 * 65536, p, C.lane); }
    }
}

__device__ __forceinline__ void late_prologue(Ctx& C, int iw, int niw) {
    LAS float* scr = (LAS float*)(C.lds + C.wave * 16384);
    const float* cw = C.in[6];
    constexpr int I_BN = 8 * 32, I_BR = 16 * 32, I_O = 16 * 32, I_UP = 16 * 128, I_DN = 64 * 32, NTR = I_BN + I_BR + I_O + I_UP + I_DN, NWIN = (NBATCH * 511) / 8;
#pragma unroll 1
    for (int t = NTR + iw; t < NTR + NWIN; t += niw) {
        const int ll = launder_v(C.lane);
        if (t < NTR) { int r = t;
            if (r < I_BN) { transpose_item(C.in[19], 512, 1024, WSP(bf16, WS_WBN), r / 32, 32 * (r % 32), 32, 32 * (r % 32), scr, ll); continue; } r -= I_BN;
            if (r < I_BR) { transpose_item(C.in[20], 1024, 1024, WSP(bf16, WS_WBR), r / 32, 32 * (r % 32), 32, 32 * (r % 32), scr, ll); continue; } r -= I_BR;
            if (r < I_O)  { transpose_item(C.in[21], 1024, 1024, WSP(bf16, WS_WO), r / 32, 32 * (r % 32), 32, 32 * (r % 32), scr, ll); continue; } r -= I_O;
            if (r < I_UP) { transpose_item(C.in[22], 1024, 4096, WSP(bf16, WS_WUP), r / 128, 32 * (r % 128), 32, 32 * (r % 128), scr, ll); continue; } r -= I_UP;
            transpose_item(C.in[23], 4096, 1024, WSP(bf16, WS_WDN), r / 32, 32 * (r % 32), 32, 32 * (r % 32), scr, ll);
        } else { const int rr0 = 8 * (t - NTR); f4 v[8];
#pragma unroll
            for (int k = 0; k < 8; ++k) { const int rr = rr0 + k; const int b = rr / 511, j = rr % 511; v[k] = __builtin_nontemporal_load((const f4*)(cw + ((size_t)b * 512 + j + 1) * 256) + ll); }
#pragma unroll
            for (int k = 0; k < 8; ++k) { const int rr = rr0 + k; const int b = rr / 511, j = rr % 511; *((f4*)(C.out + O_WINS + ((size_t)b * 512 + j) * 256) + ll) = v[k]; }
        }
    }
}

template <bool OUT_BF16, bool NT_IN = false, bool NT_OUT = false>
__device__ __forceinline__ void rmsnorm_row(const float* src, const float* g, const float* sh, const float* sc, void* dst, int lane) {
    const f4* xr = (const f4*)src + lane;
    f4 v[4]; float ss = 0.f;
#pragma unroll
    for (int j = 0; j < 4; ++j) { v[j] = NT_IN ? __builtin_nontemporal_load(xr + 64 * j) : xr[64 * j]; ss += (v[j][0] * v[j][0] + v[j][1] * v[j][1]) + (v[j][2] * v[j][2] + v[j][3] * v[j][3]); }
    const float rstd = 1.0f / sqrtf(wave_sum(ss) * (1.0f / 1024.0f) + 1e-6f);
#pragma unroll
    for (int j = 0; j < 4; ++j) {
        const int k = 4 * lane + 256 * j;
        f4 y = v[j] * rstd * *(const f4*)(g + k);
        if (sc) y = y * (*(const f4*)(sc + k) + 1.0f) + *(const f4*)(sh + k);
        if (OUT_BF16) { v2u w; w.x = cvtpk(y[0], y[1]); w.y = cvtpk(y[2], y[3]); *(v2u*)((bf16*)dst + k) = w; }
        else { if (NT_OUT) __builtin_nontemporal_store(y, (f4*)((float*)dst + k)); else *(f4*)((float*)dst + k) = y; }
    }
}

template <bool OUT_BF16, bool NT_IN, bool NT_OUT>
__device__ __forceinline__ void rmsnorm_rows4(const float* src, size_t spitch, const float* g, const float* sh, const float* sc, void* dst, size_t dpitch, int lane) {
    f4 v[4][4]; float ss[4];
#pragma unroll
    for (int q = 0; q < 4; ++q) { const f4* xr = (const f4*)(src + (size_t)q * spitch) + lane;
#pragma unroll
        for (int j = 0; j < 4; ++j) v[q][j] = NT_IN ? __builtin_nontemporal_load(xr + 64 * j) : xr[64 * j]; }
#pragma unroll
    for (int q = 0; q < 4; ++q) { float a = 0.f;
#pragma unroll
        for (int j = 0; j < 4; ++j) a += (v[q][j][0] * v[q][j][0] + v[q][j][1] * v[q][j][1]) + (v[q][j][2] * v[q][j][2] + v[q][j][3] * v[q][j][3]);
        ss[q] = a; }
#pragma unroll
    for (int q = 0; q < 4; ++q) ss[q] = 1.0f / sqrtf(wave_sum(ss[q]) * (1.0f / 1024.0f) + 1e-6f);
#pragma unroll
    for (int j = 0; j < 4; ++j) {
        const int k = 4 * lane + 256 * j;
        const f4 gv = *(const f4*)(g + k); f4 scv = {1.f, 1.f, 1.f, 1.f}, shv = {0.f, 0.f, 0.f, 0.f};
        if (sc) { scv = *(const f4*)(sc + k) + 1.0f; shv = *(const f4*)(sh + k); }
#pragma unroll
        for (int q = 0; q < 4; ++q) {
            f4 y = v[q][j] * ss[q] * gv;
            if (sc) y = y * scv + shv;
            if (OUT_BF16) { v2u w; w.x = cvtpk(y[0], y[1]); w.y = cvtpk(y[2], y[3]); *(v2u*)((bf16*)dst + (size_t)q * dpitch + k) = w; }
            else { if (NT_OUT) __builtin_nontemporal_store(y, (f4*)((float*)dst + (size_t)q * dpitch + k)); else *(f4*)((float*)dst + (size_t)q * dpitch + k) = y; }
        }
    }
}
struct EpiIn {
    static constexpr bool PERM = true, AFTER_DRAIN = false;
    unsigned char* ws; float* out;
    __device__ __forceinline__ void operator()(const f4 (&acc)[2][2][4][2], const pg8::Unit& u, int wr, int wc, int fr, int fq) const { run<2, 4>(acc, u, wr, wc, fr, fq); }
    __device__ __forceinline__ void run_main(const f4 (&acc)[2][2][4][2], const pg8::Unit& u, int wr, int wc, int fr, int fq) const {
        const int tile = u.pn, r0 = u.pm * 256 + wr * 64 + fr;
        if (tile < 5) {
            const bool rope = (tile < 2) || (wc < 2);
            f4 dc[2], ds[2];
            { const float* st = (const float*)(ws + WS_ST64) + 8 * fq; dc[0] = *(const f4*)st; dc[1] = *(const f4*)(st + 4); ds[0] = *(const f4*)(st + 32); ds[1] = *(const f4*)(st + 36); }
#pragma unroll
            for (int ai = 0; ai < 2; ++ai) { f4 c0, c1, s0, s1;
                { const float* cp = (const float*)(ws + WS_COS64) + (size_t)(r0 + 128 * ai) * 32 + 8 * fq; const float* sp = (const float*)(ws + WS_SIN64) + (size_t)(r0 + 128 * ai) * 32 + 8 * fq;
                  c0 = *(const f4*)cp; c1 = *(const f4*)(cp + 4); s0 = *(const f4*)sp; s1 = *(const f4*)(sp + 4); }
#pragma unroll
                for (int m = 0; m < 4; ++m) { const int r = r0 + 128 * ai + 16 * m;
                    const f4 a0 = acc[ai][0][m][0], a1 = acc[ai][0][m][1], b0 = acc[ai][1][m][0], b1 = acc[ai][1][m][1];
                    f4 o10 = a0, o11 = a1, o20 = b0, o21 = b1;
                    if (rope) { o10 = a0 * c0 - b0 * s0; o11 = a1 * c1 - b1 * s1; o20 = a0 * s0 + b0 * c0; o21 = a1 * s1 + b1 * c1; }
                    if (tile < 2) {
                        bf16* q = (bf16*)(ws + WS_Q) + ((size_t)r * 8 + 4 * tile + wc) * 64 + 8 * fq;
                        *(v4u*)q = pack8u(o10 * QSCALE, o11 * QSCALE); *(v4u*)(q + 32) = pack8u(o20 * QSCALE, o21 * QSCALE);
                    } else {
                        const int c_ = wc >> 1, h = wc & 1;
                        float* dst = nullptr;
                        if (tile == 2) dst = out + O_CMPP + (size_t)r * 256;
                        else if (tile == 3) dst = out + O_SELP + (size_t)r * 256;
                        else dst = (r >= T - 512) ? out + O_WINP + (size_t)(r - (T - 512)) * 256 : nullptr;
                        if (dst) { float* d0 = dst + c_ * 128 + h * 64 + 8 * fq; *(f4*)d0 = o10; *(f4*)(d0 + 4) = o11; *(f4*)(d0 + 32) = o20; *(f4*)(d0 + 36) = o21; }
                        if (tile >= 3) {
                            if (c_ == 0) { bf16* kd = (bf16*)(ws + (tile == 3 ? WS_KS : WS_KW)) + ((size_t)h * RP + r) * 64 + 8 * fq;
                                *(v4u*)kd = pack8u(o10, o11); *(v4u*)(kd + 32) = pack8u(o20, o21); }
                            else { bf16* vd = (bf16*)(ws + (tile == 3 ? WS_VST : WS_VWT)) + ((size_t)(h * 64 + 8 * fq)) * RP + r;
#pragma unroll
                                for (int j = 0; j < 4; ++j) { vd[(size_t)j * RP] = bf1(o10[j]); vd[(size_t)(4 + j) * RP] = bf1(o11[j]);
                                    vd[(size_t)(32 + j) * RP] = bf1(o20[j]); vd[(size_t)(36 + j) * RP] = bf1(o21[j]); } }
                        }
                    }
                    if (m < 3) { const f4 n0 = c0 * dc[0] - s0 * ds[0], n1 = c1 * dc[1] - s1 * ds[1]; s0 = s0 * dc[0] + c0 * ds[0]; s1 = s1 * dc[1] + c1 * ds[1]; c0 = n0; c1 = n1; }
                } }
        } else if (tile < 9) {
            const bool isk = tile >= 7; const int head = 2 * ((tile - 5) & 1) + (wc >> 1), dd0 = 32 * (wc & 1) + 8 * fq;
            f4 dc[2], ds[2]; float sclm[4];
            { const float* st = (const float*)(ws + WS_ST128) + dd0; dc[0] = *(const f4*)st; dc[1] = *(const f4*)(st + 4); ds[0] = *(const f4*)(st + 64); ds[1] = *(const f4*)(st + 68); }
#pragma unroll
            for (int m = 0; m < 4; ++m) sclm[m] = (isk ? RK_SCALE : 1.0f) * ((const float*)(ws + (isk ? WS_GINV : WS_GPOW)))[head * 132 + ((r0 + 16 * m) & 127) + 1];
#pragma unroll
            for (int ai = 0; ai < 2; ++ai) { f4 c0, c1, s0, s1;
                { const float* cp = (const float*)(ws + WS_COS128) + (size_t)(r0 + 128 * ai) * 64 + dd0; const float* sp = (const float*)(ws + WS_SIN128) + (size_t)(r0 + 128 * ai) * 64 + dd0;
                  c0 = *(const f4*)cp; c1 = *(const f4*)(cp + 4); s0 = *(const f4*)sp; s1 = *(const f4*)(sp + 4); }
#pragma unroll
                for (int m = 0; m < 4; ++m) { const int r = r0 + 128 * ai + 16 * m; const float scl = sclm[m];
                    const f4 a0 = acc[ai][0][m][0], a1 = acc[ai][0][m][1], b0 = acc[ai][1][m][0], b1 = acc[ai][1][m][1];
                    const f4 o10 = (a0 * c0 - b0 * s0) * scl, o11 = (a1 * c1 - b1 * s1) * scl, o20 = (a0 * s0 + b0 * c0) * scl, o21 = (a1 * s1 + b1 * c1) * scl;
                    bf16* nd = (bf16*)(ws + (isk ? WS_RKI : WS_RQD)) + ((size_t)r * 4 + head) * 128 + dd0;
                    *(v4u*)nd = pack8u(o10, o11); *(v4u*)(nd + 64) = pack8u(o20, o21);
                    if (isk) { bf16* td = (bf16*)(ws + WS_RKIT) + ((size_t)(head * 128 + dd0)) * RP + r;
#pragma unroll
                        for (int j = 0; j < 4; ++j) { td[(size_t)j * RP] = bf1(o10[j]); td[(size_t)(4 + j) * RP] = bf1(o11[j]);
                            td[(size_t)(64 + j) * RP] = bf1(o20[j]); td[(size_t)(68 + j) * RP] = bf1(o21[j]); } }
                    if (m < 3) { const f4 n0 = c0 * dc[0] - s0 * ds[0], n1 = c1 * dc[1] - s1 * ds[1]; s0 = s0 * dc[0] + c0 * ds[0]; s1 = s1 * dc[1] + c1 * ds[1]; c0 = n0; c1 = n1; }
                } }
        } else {
#pragma unroll
            for (int ai = 0; ai < 2; ++ai)
#pragma unroll
                for (int m = 0; m < 4; ++m) { const int r = r0 + 128 * ai + 16 * m;
                    const f4 a0 = acc[ai][0][m][0], a1 = acc[ai][0][m][1], b0 = acc[ai][1][m][0], b1 = acc[ai][1][m][1];
                    if (tile < 13) {
                        bf16* td = (bf16*)(ws + WS_RVT) + ((size_t)((tile - 9) * 256 + 32 * wc + 8 * fq)) * RP + r;
#pragma unroll
                        for (int j = 0; j < 4; ++j) { td[(size_t)j * RP] = bf1(a0[j]); td[(size_t)(4 + j) * RP] = bf1(a1[j]);
                            td[(size_t)(128 + j) * RP] = bf1(b0[j]); td[(size_t)(132 + j) * RP] = bf1(b1[j]); }
                    } else if (tile < 25) {
                        const int t4 = (tile - 13) >> 2; bf16* dst = (bf16*)(ws + (t4 == 0 ? WS_SRG : (t4 == 1 ? WS_SGA : WS_SGB))) + (size_t)r * 1024 + 256 * ((tile - 13) & 3) + 32 * wc + 8 * fq;
                        f4 x0, x1, y0, y1;
#pragma unroll
                        for (int j = 0; j < 4; ++j) { const float g0 = sigmoidf_(a0[j]), g1 = sigmoidf_(a1[j]), g2 = sigmoidf_(b0[j]), g3 = sigmoidf_(b1[j]);
                            x0[j] = t4 == 0 ? a0[j] * g0 : g0; x1[j] = t4 == 0 ? a1[j] * g1 : g1; y0[j] = t4 == 0 ? b0[j] * g2 : g2; y1[j] = t4 == 0 ? b1[j] * g3 : g3; }
                        *(v4u*)dst = pack8u(x0, x1); *(v4u*)(dst + 128) = pack8u(y0, y1);
                    } else {
                        if (wc == 0 && fq < 3) { float* gd = (float*)(ws + WS_GN) + (size_t)r * 24 + 8 * fq; f4 x0, x1;
#pragma unroll
                            for (int j = 0; j < 4; ++j) { x0[j] = sigmoidf_(a0[j]); x1[j] = sigmoidf_(a1[j]); }
                            *(f4*)gd = x0; *(f4*)(gd + 4) = x1; }
                    }
                }
        }
    }
    template <int NAI, int NM> __device__ __forceinline__ void run(const f4 (&acc)[2][2][4][2], const pg8::Unit& u, int wr, int wc, int fr, int fq) const {
        if constexpr (NAI == 2 && NM == 4) { run_main(acc, u, wr, wc, fr, fq); return; }
        const int tile = u.pn;
#pragma unroll
        for (int ai = 0; ai < NAI; ++ai)
#pragma unroll
            for (int m = 0; m < NM; ++m) {
                const int r = u.pm * 256 + ai * 128 + wr * 64 + m * 16 + fr;
                const bool is_p = r < T; const int b = r - T; const bool is_s = (!is_p) && b < NBATCH;
                const int pos = is_p ? r : T;
                const f4 a0 = acc[ai][0][m][0], a1 = acc[ai][0][m][1], b0 = acc[ai][1][m][0], b1 = acc[ai][1][m][1];
                if (tile < 5) {
                    const bool rope = (tile < 2) || (wc < 2);
                    f4 o10 = a0, o11 = a1, o20 = b0, o21 = b1;
                    if (rope) {
                        const float* cp = (const float*)(ws + WS_COS64) + (size_t)pos * 32 + 8 * fq; const float* sp = (const float*)(ws + WS_SIN64) + (size_t)pos * 32 + 8 * fq;
                        const f4 c0 = *(const f4*)cp, c1 = *(const f4*)(cp + 4), s0 = *(const f4*)sp, s1 = *(const f4*)(sp + 4);
                        o10 = a0 * c0 - b0 * s0; o11 = a1 * c1 - b1 * s1; o20 = a0 * s0 + b0 * c0; o21 = a1 * s1 + b1 * c1;
                    }
                    if (tile < 2) {
                        bf16* q = (bf16*)(ws + WS_Q) + ((size_t)r * 8 + 4 * tile + wc) * 64 + 8 * fq;
                        *(v4u*)q = pack8u(o10 * QSCALE, o11 * QSCALE); *(v4u*)(q + 32) = pack8u(o20 * QSCALE, o21 * QSCALE);
                    } else {
                        const int c_ = wc >> 1, h = wc & 1;
                        float* dst = nullptr;
                        if (tile == 2) dst = is_p ? out + O_CMPP + (size_t)r * 256 : (is_s ? out + O_CMPS + (size_t)b * 256 : nullptr);
                        else if (tile == 3) dst = is_p ? out + O_SELP + (size_t)r * 256 : (is_s ? out + O_SELS + (size_t)b * 256 : nullptr);
                        else dst = (is_p && r >= T - 512) ? out + O_WINP + (size_t)(r - (T - 512)) * 256 : (is_s ? out + O_WINS + ((size_t)b * 512 + 511) * 256 : nullptr);
                        if (dst) { float* d0 = dst + c_ * 128 + h * 64 + 8 * fq; *(f4*)d0 = o10; *(f4*)(d0 + 4) = o11; *(f4*)(d0 + 32) = o20; *(f4*)(d0 + 36) = o21; }
                        if (tile >= 3) {
                            if (c_ == 0) { bf16* kd = (bf16*)(ws + (tile == 3 ? WS_KS : WS_KW)) + ((size_t)h * RP + r) * 64 + 8 * fq;
                                *(v4u*)kd = pack8u(o10, o11); *(v4u*)(kd + 32) = pack8u(o20, o21); }
                            else { bf16* vd = (bf16*)(ws + (tile == 3 ? WS_VST : WS_VWT)) + ((size_t)(h * 64 + 8 * fq)) * RP + r;
#pragma unroll
                                for (int j = 0; j < 4; ++j) { vd[(size_t)j * RP] = bf1(o10[j]); vd[(size_t)(4 + j) * RP] = bf1(o11[j]);
                                    vd[(size_t)(32 + j) * RP] = bf1(o20[j]); vd[(size_t)(36 + j) * RP] = bf1(o21[j]); } }
                        }
                    }
                } else if (tile < 9) {
                    const bool isk = tile >= 7; const int head = 2 * ((tile - 5) & 1) + (wc >> 1), dd0 = 32 * (wc & 1) + 8 * fq;
                    const float* cp = (const float*)(ws + WS_COS128) + (size_t)pos * 64 + dd0; const float* sp = (const float*)(ws + WS_SIN128) + (size_t)pos * 64 + dd0;
                    const f4 c0 = *(const f4*)cp, c1 = *(const f4*)(cp + 4), s0 = *(const f4*)sp, s1 = *(const f4*)(sp + 4);
                    float scl = isk ? RK_SCALE : 1.0f;
                    if (is_p) scl *= ((const float*)(ws + (isk ? WS_GINV : WS_GPOW)))[head * 132 + (r & 127) + 1];
                    const f4 o10 = (a0 * c0 - b0 * s0) * scl, o11 = (a1 * c1 - b1 * s1) * scl, o20 = (a0 * s0 + b0 * c0) * scl, o21 = (a1 * s1 + b1 * c1) * scl;
                    bf16* nd = (bf16*)(ws + (isk ? WS_RKI : WS_RQD)) + ((size_t)r * 4 + head) * 128 + dd0;
                    *(v4u*)nd = pack8u(o10, o11); *(v4u*)(nd + 64) = pack8u(o20, o21);
                    if (isk) { bf16* td = (bf16*)(ws + WS_RKIT) + ((size_t)(head * 128 + dd0)) * RP + r;
#pragma unroll
                        for (int j = 0; j < 4; ++j) { td[(size_t)j * RP] = bf1(o10[j]); td[(size_t)(4 + j) * RP] = bf1(o11[j]);
                            td[(size_t)(64 + j) * RP] = bf1(o20[j]); td[(size_t)(68 + j) * RP] = bf1(o21[j]); } }
                } else if (tile < 13) {
                    bf16* td = (bf16*)(ws + WS_RVT) + ((size_t)((tile - 9) * 256 + 32 * wc + 8 * fq)) * RP + r;
#pragma unroll
                    for (int j = 0; j < 4; ++j) { td[(size_t)j * RP] = bf1(a0[j]); td[(size_t)(4 + j) * RP] = bf1(a1[j]);
                        td[(size_t)(128 + j) * RP] = bf1(b0[j]); td[(size_t)(132 + j) * RP] = bf1(b1[j]); }
                } else if (tile < 25) {
                    const int t4 = (tile - 13) >> 2; bf16* dst = (bf16*)(ws + (t4 == 0 ? WS_SRG : (t4 == 1 ? WS_SGA : WS_SGB))) + (size_t)r * 1024 + 256 * ((tile - 13) & 3) + 32 * wc + 8 * fq;
                    f4 x0, x1, y0, y1;
#pragma unroll
                    for (int j = 0; j < 4; ++j) { const float g0 = sigmoidf_(a0[j]), g1 = sigmoidf_(a1[j]), g2 = sigmoidf_(b0[j]), g3 = sigmoidf_(b1[j]);
                        x0[j] = t4 == 0 ? a0[j] * g0 : g0; x1[j] = t4 == 0 ? a1[j] * g1 : g1; y0[j] = t4 == 0 ? b0[j] * g2 : g2; y1[j] = t4 == 0 ? b1[j] * g3 : g3; }
                    *(v4u*)dst = pack8u(x0, x1); *(v4u*)(dst + 128) = pack8u(y0, y1);
                } else {
                    if (wc == 0 && fq < 3) { float* gd = (float*)(ws + WS_GN) + (size_t)r * 24 + 8 * fq; f4 x0, x1;
#pragma unroll
                        for (int j = 0; j < 4; ++j) { x0[j] = sigmoidf_(a0[j]); x1[j] = sigmoidf_(a1[j]); }
                        *(f4*)gd = x0; *(f4*)(gd + 4) = x1; }
                }
            }
    }
};
__device__ __forceinline__ void bf8_to_f(const v4u w, f4& a, f4& b) {
    a[0] = __builtin_bit_cast(float, w.x << 16); a[1] = __builtin_bit_cast(float, w.x & 0xffff0000u); a[2] = __builtin_bit_cast(float, w.y << 16); a[3] = __builtin_bit_cast(float, w.y & 0xffff0000u);
    b[0] = __builtin_bit_cast(float, w.z << 16); b[1] = __builtin_bit_cast(float, w.z & 0xffff0000u); b[2] = __builtin_bit_cast(float, w.w << 16); b[3] = __builtin_bit_cast(float, w.w & 0xffff0000u);
}
struct EpiMixA {
    static constexpr bool PERM = true, AFTER_DRAIN = false;
    unsigned char* ws;
    __device__ __forceinline__ void operator()(const f4 (&acc)[2][2][4][2], const pg8::Unit& u, int wr, int wc, int fr, int fq) const { run<2, 4>(acc, u, wr, wc, fr, fq); }
    template <int NAI, int NM> __device__ __forceinline__ void run(const f4 (&acc)[2][2][4][2], const pg8::Unit& u, int wr, int wc, int fr, int fq) const {
        const size_t o0 = (size_t)(u.pm * 256 + wr * 64 + fr) * 1024 + u.pn * 256 + 32 * wc + 8 * fq;
        v4u gt[NAI][NM][2];
#pragma unroll
        for (int ai = 0; ai < NAI; ++ai)
#pragma unroll
            for (int m = 0; m < NM; ++m)
#pragma unroll
                for (int bj = 0; bj < 2; ++bj) gt[ai][m][bj] = *(const v4u*)((const bf16*)(ws + WS_SGA) + o0 + (size_t)(ai * 128 + m * 16) * 1024 + 128 * bj);
#pragma unroll
        for (int ai = 0; ai < NAI; ++ai)
#pragma unroll
            for (int m = 0; m < NM; ++m)
#pragma unroll
                for (int bj = 0; bj < 2; ++bj) { f4 g0, g1; bf8_to_f(gt[ai][m][bj], g0, g1);
                    *(v4u*)((bf16*)(ws + WS_MIXA) + o0 + (size_t)(ai * 128 + m * 16) * 1024 + 128 * bj) = pack8u(acc[ai][bj][m][0] * g0, acc[ai][bj][m][1] * g1); }
    }
};
struct EpiMixed {
    static constexpr bool PERM = true, AFTER_DRAIN = false;
    unsigned char* ws;
    __device__ __forceinline__ void operator()(const f4 (&acc)[2][2][4][2], const pg8::Unit& u, int wr, int wc, int fr, int fq) const { run<2, 4>(acc, u, wr, wc, fr, fq); }
    template <int NAI, int NM> __device__ __forceinline__ void run(const f4 (&acc)[2][2][4][2], const pg8::Unit& u, int wr, int wc, int fr, int fq) const {
        const size_t o0 = (size_t)(u.pm * 256 + wr * 64 + fr) * 1024 + u.pn * 256 + 32 * wc + 8 * fq;
#pragma unroll
        for (int ai = 0; ai < NAI; ++ai) {
            v4u gt[NM][2], mt[NM][2];
#pragma unroll
            for (int m = 0; m < NM; ++m)
#pragma unroll
                for (int bj = 0; bj < 2; ++bj) { const size_t o = o0 + (size_t)(ai * 128 + m * 16) * 1024 + 128 * bj;
                    gt[m][bj] = *(const v4u*)((const bf16*)(ws + WS_SGB) + o); mt[m][bj] = *(const v4u*)((const bf16*)(ws + WS_MIXA) + o); }
#pragma unroll
            for (int m = 0; m < NM; ++m)
#pragma unroll
                for (int bj = 0; bj < 2; ++bj) { const size_t o = o0 + (size_t)(ai * 128 + m * 16) * 1024 + 128 * bj;
                    f4 g0, g1, m0, m1; bf8_to_f(gt[m][bj], g0, g1); bf8_to_f(mt[m][bj], m0, m1);
                    *(v4u*)((bf16*)(ws + WS_MIXED) + o) = pack8u(m0 + acc[ai][bj][m][0] * g0, m1 + acc[ai][bj][m][1] * g1); }
        }
    }
};
struct EpiResid {
    static constexpr bool PERM = true, AFTER_DRAIN = false;
    unsigned char* ws; const float* xp; const float* xs; int gate_off; bool first;
    __device__ __forceinline__ void operator()(const f4 (&acc)[2][2][4][2], const pg8::Unit& u, int wr, int wc, int fr, int fq) const { run<2, 4>(acc, u, wr, wc, fr, fq); }
    __device__ __forceinline__ void run_main(const f4 (&acc)[2][2][4][2], const pg8::Unit& u, int wr, int wc, int fr, int fq) const {
        const int r0 = u.pm * 256 + wr * 64 + fr, c0 = u.pn * 256 + 32 * wc + 8 * fq;
        f4 gz[2][2];
#pragma unroll
        for (int bj = 0; bj < 2; ++bj) { const float* gate = (const float*)(ws + WS_MOD) + gate_off + c0 + 128 * bj; gz[bj][0] = *(const f4*)gate; gz[bj][1] = *(const f4*)(gate + 4); }
        const float* basep = first ? xp : (const float*)(ws + WS_X1);
        float* outp = (float*)(ws + (first ? WS_X1 : WS_X2));
#pragma unroll
        for (int ai = 0; ai < 2; ++ai) {
            f4 bv[4][2][2];
#pragma unroll
            for (int m = 0; m < 4; ++m)
#pragma unroll
                for (int bj = 0; bj < 2; ++bj) { const float* bp = basep + (size_t)(r0 + 128 * ai + 16 * m) * 1024 + c0 + 128 * bj;
                    bv[m][bj][0] = __builtin_nontemporal_load((const f4*)bp); bv[m][bj][1] = __builtin_nontemporal_load((const f4*)(bp + 4)); }
#pragma unroll
            for (int m = 0; m < 4; ++m)
#pragma unroll
                for (int bj = 0; bj < 2; ++bj) { float* xo = outp + (size_t)(r0 + 128 * ai + 16 * m) * 1024 + c0 + 128 * bj;
                    *(f4*)xo = bv[m][bj][0] + gz[bj][0] * acc[ai][bj][m][0]; *(f4*)(xo + 4) = bv[m][bj][1] + gz[bj][1] * acc[ai][bj][m][1]; }
        }
    }
    template <int NAI, int NM> __device__ __forceinline__ void run(const f4 (&acc)[2][2][4][2], const pg8::Unit& u, int wr, int wc, int fr, int fq) const {
        if constexpr (NAI == 2 && NM == 4) { run_main(acc, u, wr, wc, fr, fq); return; }
#pragma unroll
        for (int ai = 0; ai < NAI; ++ai)
#pragma unroll
            for (int m = 0; m < NM; ++m) { const int r = u.pm * 256 + ai * 128 + wr * 64 + m * 16 + fr;
                const int b = r - T; const int modrow = r < T ? 0 : (b < NBATCH ? b + 1 : 0);
                const float* gate = (const float*)(ws + WS_MOD) + (size_t)modrow * 6144 + gate_off;
                float* x1 = (float*)(ws + (first ? WS_X1 : WS_X2)) + (size_t)r * 1024;
                const float* base = first ? (r < T ? xp + (size_t)r * 1024 : (b < NBATCH ? xs + (size_t)b * 1024 : nullptr)) : (const float*)(ws + WS_X1) + (size_t)r * 1024;
#pragma unroll
                for (int bj = 0; bj < 2; ++bj) { const int c = u.pn * 256 + 128 * bj + 32 * wc + 8 * fq;
                    f4 v0 = {0.f, 0.f, 0.f, 0.f}, v1 = v0; if (base) { v0 = __builtin_nontemporal_load((const f4*)(base + c)); v1 = __builtin_nontemporal_load((const f4*)(base + c + 4)); }
                    v0 += *(const f4*)(gate + c) * acc[ai][bj][m][0]; v1 += *(const f4*)(gate + c + 4) * acc[ai][bj][m][1];
                    *(f4*)(x1 + c) = v0; *(f4*)(x1 + c + 4) = v1; } }
    }
};
struct EpiUp {
    static constexpr bool PERM = true, AFTER_DRAIN = false;
    unsigned char* ws;
    __device__ __forceinline__ void operator()(const f4 (&acc)[2][2][4][2], const pg8::Unit& u, int wr, int wc, int fr, int fq) const { run<2, 4>(acc, u, wr, wc, fr, fq); }
    template <int NAI, int NM> __device__ __forceinline__ void run(const f4 (&acc)[2][2][4][2], const pg8::Unit& u, int wr, int wc, int fr, int fq) const {
#pragma unroll
        for (int ai = 0; ai < NAI; ++ai)
#pragma unroll
            for (int m = 0; m < NM; ++m) { const size_t r = (size_t)(u.pm * 256 + ai * 128 + wr * 64 + m * 16 + fr);
#pragma unroll
                for (int bj = 0; bj < 2; ++bj) { const size_t o = r * 4096 + u.pn * 256 + 128 * bj + 32 * wc + 8 * fq;
                    f4 v0 = acc[ai][bj][m][0], v1 = acc[ai][bj][m][1];
#pragma unroll
                    for (int j = 0; j < 4; ++j) { const float p = fmaxf(v0[j], 0.f), q = fmaxf(v1[j], 0.f); v0[j] = p * p; v1[j] = q * q; }
                    *(v4u*)((bf16*)(ws + WS_UP) + o) = pack8u(v0, v1); } }
    }
};

template <class Epi>
__device__ __forceinline__ void skinny_subunit(Ctx& C, const bf16* A, const bf16* Bt, int K, int pn, int wcs, const Epi& E) {
    const int lane = C.lane, r = lane & 15, fq = lane >> 4, w = C.wave;
    const int kw = K >> 3;
    f4 acc[2][2][2];
#pragma unroll
    for (int i = 0; i < 8; ++i) acc[i >> 2][(i >> 1) & 1][i & 1] = (f4){0.f, 0.f, 0.f, 0.f};
    const bf16* ap = A + (size_t)(T + r) * K + w * kw + 8 * fq;
    const bf16* bp = Bt + (size_t)(256 * pn + 32 * wcs + 8 * (r >> 2) + (r & 3)) * K + w * kw + 8 * fq;
#pragma unroll 2
    for (int ks = 0; ks < kw; ks += 32) {
        bf16x8 af[2], wf[2][2];
#pragma unroll
        for (int m = 0; m < 2; ++m) af[m] = *(const bf16x8*)(ap + (size_t)(16 * m) * K + ks);
#pragma unroll
        for (int bj = 0; bj < 2; ++bj)
#pragma unroll
            for (int n = 0; n < 2; ++n) wf[bj][n] = *(const bf16x8*)(bp + (size_t)(128 * bj + 4 * n) * K + ks);
#pragma unroll
        for (int bj = 0; bj < 2; ++bj)
#pragma unroll
            for (int m = 0; m < 2; ++m)
#pragma unroll
                for (int n = 0; n < 2; ++n) acc[bj][m][n] = MFMA16(wf[bj][n], af[m], acc[bj][m][n]);
    }
    LAS f4* red = (LAS f4*)C.lds;
#pragma unroll
    for (int i = 0; i < 8; ++i) red[(w * 8 + i) * 64 + lane] = acc[i >> 2][(i >> 1) & 1][i & 1];
    __syncthreads();
    { f4 sacc = red[w * 64 + lane];
#pragma unroll
      for (int ww = 1; ww < 8; ++ww) sacc += red[(ww * 8 + w) * 64 + lane];
      red[(64 + w) * 64 + lane] = sacc; }
    __syncthreads();
    if (w == 0) {
        f4 full[2][2][4][2];
#pragma unroll
        for (int i = 0; i < 8; ++i) full[0][i >> 2][(i >> 1) & 1][i & 1] = red[(64 + i) * 64 + lane];
        E.template run<1, 2>(full, pg8::Unit{64, pn}, 0, wcs, r, fq);
    }
    __syncthreads();
}
template <class Epi>
__device__ __forceinline__ void skinny_phase(Ctx& C, const bf16* A, const bf16* Bt, int N, int K, const Epi& E) {
    const int nsub = (N >> 8) * 4, off = (64 * (N >> 8)) % C.nb;
    A = launder_p(A); Bt = launder_p(Bt); C.tid = launder_v(C.tid); C.lane = C.tid & 63;
    int su = C.bid - off; if (su < 0) su += C.nb;
#pragma unroll 1
    for (; su < nsub; su += C.nb) skinny_subunit(C, A, Bt, K, su >> 2, su & 3, E);
}

struct AttnAcc { float m, l; f4 o[4]; };
__device__ __forceinline__ void attn_init(AttnAcc& a) { a.m = -1e30f; a.l = 0.f;
#pragma unroll
    for (int c = 0; c < 4; ++c) a.o[c] = (f4){0.f, 0.f, 0.f, 0.f}; }
struct SrcB { const bf16* K; const bf16* VT; int pitch; };
struct SrcF { const float* base; int koff, voff, nrows; };
__device__ __forceinline__ void load_k(const SrcB& s, int kb, int lane, bf16x8 (&kf)[2][2]) {
    const int r = lane & 15, fq = lane >> 4;
#pragma unroll
    for (int kt = 0; kt < 2; ++kt) { const bf16* p = s.K + (size_t)(kb + 8 * (r >> 2) + 4 * kt + (r & 3)) * 64 + 8 * fq; kf[kt][0] = *(const bf16x8*)p; kf[kt][1] = *(const bf16x8*)(p + 32); }
}
__device__ __forceinline__ void load_v(const SrcB& s, int kb, int lane, bf16x8 (&vf)[4]) {
    const int r = lane & 15, fq = lane >> 4;
#pragma unroll
    for (int c = 0; c < 4; ++c) vf[c] = *(const bf16x8*)(s.VT + (size_t)(16 * c + r) * s.pitch + kb + 8 * fq);
}
__device__ __forceinline__ void load_k(const SrcF& s, int kb, int lane, bf16x8 (&kf)[2][2]) {
    const int r = lane & 15, fq = lane >> 4;
#pragma unroll
    for (int kt = 0; kt < 2; ++kt) { int key = kb + 8 * (r >> 2) + 4 * kt + (r & 3); key = key < s.nrows ? key : s.nrows - 1;
        const float* p = s.base + (size_t)key * 256 + s.koff + 8 * fq;
        kf[kt][0] = pack8(*(const f4*)p, *(const f4*)(p + 4)); kf[kt][1] = pack8(*(const f4*)(p + 32), *(const f4*)(p + 36)); }
}
__device__ __forceinline__ void load_v(const SrcF& s, int kb, int lane, bf16x8 (&vf)[4]) {
    const int r = lane & 15, fq = lane >> 4;
#pragma unroll
    for (int c = 0; c < 4; ++c) { f4 x, y;
#pragma unroll
        for (int j = 0; j < 4; ++j) { int k0 = kb + 8 * fq + j, k1 = k0 + 4; k0 = k0 < s.nrows ? k0 : s.nrows - 1; k1 = k1 < s.nrows ? k1 : s.nrows - 1;
            x[j] = s.base[(size_t)k0 * 256 + s.voff + 16 * c + r]; y[j] = s.base[(size_t)k1 * 256 + s.voff + 16 * c + r]; }
        vf[c] = pack8(x, y); }
}
__device__ __forceinline__ void qk_scores(const bf16x8 (&kf)[2][2], const bf16x8 (&bq)[2], f4& s0, f4& s1) {
    s0 = (f4){0.f, 0.f, 0.f, 0.f}; s1 = s0;
    s0 = MFMA16(kf[0][0], bq[0], s0); s0 = MFMA16(kf[0][1], bq[1], s0);
    s1 = MFMA16(kf[1][0], bq[0], s1); s1 = MFMA16(kf[1][1], bq[1], s1);
}
constexpr float MAX_SLACK = 8.0f;
template <class Mask>
__device__ __forceinline__ void attn_chunk(AttnAcc& a, const bf16x8 (&kf)[2][2], const bf16x8 (&vf)[4], const bf16x8 (&bq)[2], int kb, int fq, const Mask& mask) {
    f4 s0, s1; qk_scores(kf, bq, s0, s1);
    bool v0[4], v1[4]; float mx = -1e30f;
#pragma unroll
    for (int j = 0; j < 4; ++j) { v0[j] = mask(kb + 8 * fq + j); v1[j] = mask(kb + 8 * fq + 4 + j); mx = fmaxf(mx, v0[j] ? s0[j] : -1e30f); mx = fmaxf(mx, v1[j] ? s1[j] : -1e30f); }
    if (__any(mx > a.m + MAX_SLACK)) {
        mx = fmaxf(mx, __shfl_xor(mx, 16)); mx = fmaxf(mx, __shfl_xor(mx, 32));
        const float mn = fmaxf(a.m, mx), alpha = fexp2(a.m - mn); a.m = mn; a.l *= alpha;
#pragma unroll
        for (int c = 0; c < 4; ++c) a.o[c] = a.o[c] * alpha;
    }
    f4 p0, p1; float ps = 0.f;
#pragma unroll
    for (int j = 0; j < 4; ++j) { p0[j] = v0[j] ? fexp2(s0[j] - a.m) : 0.f; p1[j] = v1[j] ? fexp2(s1[j] - a.m) : 0.f; ps += p0[j] + p1[j]; }
    a.l += ps;
    const bf16x8 pb = pack8(p0, p1);
#pragma unroll
    for (int c = 0; c < 4; ++c) a.o[c] = MFMA16(vf[c], pb, a.o[c]);
}
__device__ __forceinline__ void attn_tile64_full(AttnAcc& a, const bf16x8 (&kf)[2][2][2], const bf16x8 (&vf)[2][4], const bf16x8 (&bq)[2], float colbias = 0.f) {
    f4 s[2][2];
#pragma unroll
    for (int ch = 0; ch < 2; ++ch)
#pragma unroll
        for (int kt = 0; kt < 2; ++kt) { f4 t = (f4){colbias, colbias, colbias, colbias}; t = MFMA16(kf[ch][kt][0], bq[0], t); s[ch][kt] = MFMA16(kf[ch][kt][1], bq[1], t); }
    float mx = -1e30f;
#pragma unroll
    for (int ch = 0; ch < 2; ++ch)
#pragma unroll
        for (int h = 0; h < 2; ++h) mx = fmaxf(mx, fmaxf(fmaxf(s[ch][h][0], s[ch][h][1]), fmaxf(s[ch][h][2], s[ch][h][3])));
    if (__any(mx > a.m + MAX_SLACK)) {
        mx = fmaxf(mx, __shfl_xor(mx, 16)); mx = fmaxf(mx, __shfl_xor(mx, 32));
        const float mn = fmaxf(a.m, mx), alpha = fexp2(a.m - mn); a.m = mn; a.l *= alpha;
#pragma unroll
        for (int c = 0; c < 4; ++c) a.o[c] = a.o[c] * alpha;
    }
    float ps = 0.f; bf16x8 pb[2];
#pragma unroll
    for (int ch = 0; ch < 2; ++ch) { f4 p0, p1;
#pragma unroll
        for (int j = 0; j < 4; ++j) { p0[j] = fexp2(s[ch][0][j] - a.m); p1[j] = fexp2(s[ch][1][j] - a.m); ps += p0[j] + p1[j]; }
        pb[ch] = pack8(p0, p1); }
    a.l += ps;
#pragma unroll
    for (int ch = 0; ch < 2; ++ch)
#pragma unroll
        for (int c = 0; c < 4; ++c) a.o[c] = MFMA16(vf[ch][c], pb[ch], a.o[c]);
}
template <class Mask>
__device__ __forceinline__ void attn_tile64(AttnAcc& a, const bf16x8 (&kf)[2][2][2], const bf16x8 (&vf)[2][4], const bf16x8 (&bq)[2], int kb, int fq, const Mask& mask) {
    f4 s[2][2];
#pragma unroll
    for (int ch = 0; ch < 2; ++ch) qk_scores(kf[ch], bq, s[ch][0], s[ch][1]);
    bool v[2][2][4]; float mx = -1e30f;
#pragma unroll
    for (int ch = 0; ch < 2; ++ch)
#pragma unroll
        for (int h = 0; h < 2; ++h)
#pragma unroll
            for (int j = 0; j < 4; ++j) { v[ch][h][j] = mask(kb + 32 * ch + 8 * fq + 4 * h + j); mx = fmaxf(mx, v[ch][h][j] ? s[ch][h][j] : -1e30f); }
    if (__any(mx > a.m + MAX_SLACK)) {
        mx = fmaxf(mx, __shfl_xor(mx, 16)); mx = fmaxf(mx, __shfl_xor(mx, 32));
        const float mn = fmaxf(a.m, mx), alpha = fexp2(a.m - mn); a.m = mn; a.l *= alpha;
#pragma unroll
        for (int c = 0; c < 4; ++c) a.o[c] = a.o[c] * alpha;
    }
    float ps = 0.f; bf16x8 pb[2];
#pragma unroll
    for (int ch = 0; ch < 2; ++ch) { f4 p0, p1;
#pragma unroll
        for (int j = 0; j < 4; ++j) { p0[j] = v[ch][0][j] ? fexp2(s[ch][0][j] - a.m) : 0.f; p1[j] = v[ch][1][j] ? fexp2(s[ch][1][j] - a.m) : 0.f; ps += p0[j] + p1[j]; }
        pb[ch] = pack8(p0, p1); }
    a.l += ps;
#pragma unroll
    for (int ch = 0; ch < 2; ++ch)
#pragma unroll
        for (int c = 0; c < 4; ++c) a.o[c] = MFMA16(vf[ch][c], pb[ch], a.o[c]);
}
__device__ __forceinline__ void select_blocks(const LAS float* sc, LAS unsigned* selm, int jhi, int f1, int f2, int lane) {
    unsigned key[4]; bool cand[4];
#pragma unroll
    for (int rr = 0; rr < 4; ++rr) { const int j = 4 * lane + rr; cand[rr] = (j >= 1) && (j <= jhi); key[rr] = cand[rr] ? __builtin_bit_cast(unsigned, sc[j]) : 0u; }
    unsigned prefix = 0u;
#pragma unroll 1
    for (int bit = 30; bit >= 0; --bit) {
        const unsigned c = prefix | (1u << bit); int cnt = 0;
#pragma unroll
        for (int rr = 0; rr < 4; ++rr) cnt += __popcll(__ballot(cand[rr] && key[rr] >= c));
        if (cnt >= 13) prefix = c;
    }
    int cgt = 0; unsigned long long be[4];
#pragma unroll
    for (int rr = 0; rr < 4; ++rr) { cgt += __popcll(__ballot(cand[rr] && key[rr] > prefix)); be[rr] = __ballot(cand[rr] && key[rr] == prefix); }
    const int need = 13 - cgt; const unsigned long long lt = (1ull << lane) - 1ull;
    int before = 0;
#pragma unroll
    for (int rr = 0; rr < 4; ++rr) before += __popcll(be[rr] & lt);
    unsigned nib = 0u;
#pragma unroll
    for (int rr = 0; rr < 4; ++rr) { const int j = 4 * lane + rr; const bool eq = cand[rr] && key[rr] == prefix;
        const bool sel = (cand[rr] && key[rr] > prefix) || (eq && before < need) || (j == 0) || (j == f1) || (j == f2);
        before += eq ? 1 : 0; nib |= sel ? (1u << rr) : 0u; }
    if (lane < 8) selm[lane] = 0u;
    WAVE_SYNC();
    __hip_atomic_fetch_or(selm + (lane >> 3), nib << (4 * (lane & 7)), __ATOMIC_RELAXED, __HIP_MEMORY_SCOPE_WORKGROUP);
    WAVE_SYNC();
}
template <class Src, class Mask>
__device__ __forceinline__ void attn_range(AttnAcc& a, const Src& src, const bf16x8 (&bq)[2], int kb0, int kb1, int lane, const Mask& mask) {
    if (kb0 >= kb1) return;
    bf16x8 kf[2][2], vf[4]; load_k(src, kb0, lane, kf); load_v(src, kb0, lane, vf);
    for (int kb = kb0; kb < kb1; kb += 32) {
        bf16x8 kn[2][2], vn[4]; const int kbn = (kb + 32 < kb1) ? kb + 32 : kb;
        load_k(src, kbn, lane, kn); load_v(src, kbn, lane, vn);
        attn_chunk(a, kf, vf, bq, kb, lane >> 4, mask);
#pragma unroll
        for (int i = 0; i < 2; ++i) { kf[i][0] = kn[i][0]; kf[i][1] = kn[i][1]; }
#pragma unroll
        for (int c = 0; c < 4; ++c) vf[c] = vn[c];
    }
}
__device__ __forceinline__ float col_total(float l) { l += __shfl_xor(l, 16); l += __shfl_xor(l, 32); return l; }

template <bool SAMPLE>
__device__ __forceinline__ void nsa_task(Ctx& C, int task) {
    const int lane = C.lane, r = lane & 15, fq = lane >> 4, qi = r >> 2, g = r & 3;
    LAS float* SC = (LAS float*)(C.lds + C.wave * 16384);
    LAS unsigned* SELM = (LAS unsigned*)(C.lds + C.wave * 16384 + 4096);
    const int kvh = task & 1, b = task >> 1, t0 = SAMPLE ? T : 4 * (task >> 1);
    const int tl = SAMPLE ? T : t0 + qi;
    const int rowq = SAMPLE ? T + b : tl;
    const int head = kvh * 4 + g;
    bf16x8 bq[2];
    { const bf16* qp = WSP(bf16, WS_Q) + ((size_t)rowq * 8 + head) * 64 + 8 * fq; bq[0] = *(const bf16x8*)qp; bq[1] = *(const bf16x8*)(qp + 32); }
    const float* gn = WSP(float, WS_GN) + (size_t)rowq * 24 + head * 3;
    const float g_c = gn[0], g_s = gn[1], g_w = gn[2];
    f4 outv[4];
    {
        const SrcB src = SAMPLE ? SrcB{WSP(bf16, WS_CMPKS) + (size_t)(b * 2 + kvh) * 65536, WSP(bf16, WS_CMPVS) + (size_t)(b * 2 + kvh) * 65536, 1024}
                                : SrcB{WSP(bf16, WS_CMPKP) + (size_t)kvh * 65536, WSP(bf16, WS_CMPVP) + (size_t)kvh * 65536, 1024};
        const int nvis = tl >= 31 ? ((tl - 31) >> 4) + 1 : 0;
        const int tmax = SAMPLE ? T : t0 + 3; const int nvmax = tmax >= 31 ? ((tmax - 31) >> 4) + 1 : 0;
        const int kend = ((nvmax + 31) >> 5) << 5;
        float m = -1e30f, l = 0.f;
        for (int kb = 0; kb < kend; kb += 32) {
            bf16x8 kf[2][2]; load_k(src, kb, lane, kf);
            f4 s0, s1; qk_scores(kf, bq, s0, s1);
            float mx = -1e30f;
#pragma unroll
            for (int j = 0; j < 4; ++j) { mx = fmaxf(mx, (kb + 8 * fq + j < nvis) ? s0[j] : -1e30f); mx = fmaxf(mx, (kb + 8 * fq + 4 + j < nvis) ? s1[j] : -1e30f); }
            if (__any(mx > m + MAX_SLACK)) { mx = fmaxf(mx, __shfl_xor(mx, 16)); mx = fmaxf(mx, __shfl_xor(mx, 32));
                const float mn = fmaxf(m, mx); l *= fexp2(m - mn); m = mn; }
            float ps = 0.f;
#pragma unroll
            for (int j = 0; j < 4; ++j) { ps += (kb + 8 * fq + j < nvis) ? fexp2(s0[j] - m) : 0.f; ps += (kb + 8 * fq + 4 + j < nvis) ? fexp2(s1[j] - m) : 0.f; }
            l += ps;
        }
        l = col_total(l); const float il = l > 0.f ? 1.0f / l : 0.f;
#pragma unroll
        for (int i = 0; i < 16; ++i) SC[lane * 16 + i] = 0.f;
        WAVE_SYNC();
        f4 o[4];
#pragma unroll
        for (int c = 0; c < 4; ++c) o[c] = (f4){0.f, 0.f, 0.f, 0.f};
        float tprev = 0.f;
        for (int kb = 0; kb < kend; kb += 32) {
            bf16x8 kf[2][2], vf[4]; load_k(src, kb, lane, kf); load_v(src, kb, lane, vf);
            f4 s0, s1; qk_scores(kf, bq, s0, s1);
            f4 p0, p1;
#pragma unroll
            for (int j = 0; j < 4; ++j) { p0[j] = (kb + 8 * fq + j < nvis) ? fexp2(s0[j] - m) * il : 0.f; p1[j] = (kb + 8 * fq + 4 + j < nvis) ? fexp2(s1[j] - m) * il : 0.f; }
            const bf16x8 pb = pack8(p0, p1);
#pragma unroll
            for (int c = 0; c < 4; ++c) o[c] = MFMA16(vf[c], pb, o[c]);
            const float tcur = p1[3];
            const float up_same = __shfl(tcur, (lane + 48) & 63), up_prev = __shfl(tprev, (lane + 48) & 63);
            tprev = tcur;
            float g0 = (p0[0] + p0[1]) + (p0[2] + p0[3]) + (fq ? up_same : up_prev);
            float g1 = (p1[0] + p1[1]) + (p1[2] + p1[3]) + p0[3];
            g0 += __shfl_xor(g0, 1); g0 += __shfl_xor(g0, 2); g1 += __shfl_xor(g1, 1); g1 += __shfl_xor(g1, 2);
            { const int jb = (kb >> 2) + 2 * fq; SC[qi * 256 + jb] = g0; SC[qi * 256 + jb + 1] = g1; }
        }
#pragma unroll
        for (int c = 0; c < 4; ++c) outv[c] = o[c] * g_c;
    }
    WAVE_SYNC();
    {
        constexpr int NQ = SAMPLE ? 1 : 4;
#pragma unroll 1
        for (int q = 0; q < NQ; ++q) {
            const int tq = SAMPLE ? T : t0 + q; const int qblk = tq >> 6;
            if (!SAMPLE && qblk < 16) { if (lane < 8) SELM[q * 8 + lane] = (lane == 0) ? ((1u << (qblk + 1)) - 1u) : 0u; }
            else select_blocks(SC + q * 256, SELM + q * 8, SAMPLE ? 254 : qblk - 2, SAMPLE ? 255 : qblk, SAMPLE ? 255 : qblk - 1, lane);
        }
    }
    WAVE_SYNC();
    {
        AttnAcc a; attn_init(a);
        const int qsel = SAMPLE ? 0 : qi;
#pragma unroll
        for (int w = 0; w < 8; ++w) {
            const unsigned mw = SELM[qsel * 8 + w];
            unsigned uw = SAMPLE ? SELM[w] : (SELM[w] | SELM[8 + w] | SELM[16 + w] | SELM[24 + w]);
            uw = (unsigned)__builtin_amdgcn_readfirstlane((int)uw);
            while (uw) {
                const int bit = __builtin_ctz(uw); uw &= uw - 1u; const int blk = 32 * w + bit;
                const bool mysel = (mw >> bit) & 1u;
                if (SAMPLE) {
                    const int phys = ((const int*)C.in[8])[b * 128 + (blk >> 1)];
                    const SrcF src{C.in[5] + ((size_t)phys * 128 + (size_t)(blk & 1) * 64) * 256, kvh * 64, 128 + kvh * 64, 64};
                    attn_range(a, src, bq, 0, 64, lane, [&](int) { return mysel; });
                } else {
                    const SrcB src{WSP(bf16, WS_KS) + (size_t)kvh * RP * 64, WSP(bf16, WS_VST) + (size_t)kvh * 64 * RP, RP};
                    attn_range(a, src, bq, 64 * blk, 64 * blk + 64, lane, [&](int key) { return mysel && key <= tl; });
                }
            }
        }
        if (SAMPLE) {
            const SrcF src{C.out + O_SELS + (size_t)b * 256, kvh * 64, 128 + kvh * 64, 1};
            attn_range(a, src, bq, 0, 32, lane, [&](int key) { return key == 0; });
        }
        const float l = col_total(a.l); const float sc = l > 0.f ? g_s / l : 0.f;
#pragma unroll
        for (int c = 0; c < 4; ++c) outv[c] += a.o[c] * sc;
    }
    {
        AttnAcc a; attn_init(a);
        if (SAMPLE) {
            const SrcF src{C.out + O_WINS + (size_t)b * 512 * 256, kvh * 64, 128 + kvh * 64, 512};
            attn_range(a, src, bq, 0, 512, lane, [&](int) { return true; });
        } else {
            const SrcB src{WSP(bf16, WS_KW) + (size_t)kvh * RP * 64, WSP(bf16, WS_VWT) + (size_t)kvh * 64 * RP, RP};
            int k0 = t0 - 511; k0 = k0 < 0 ? 0 : k0; k0 &= ~31;
            attn_range(a, src, bq, k0, t0 + 4, lane, [&](int key) { return key <= tl && key > tl - 512; });
        }
        const float l = col_total(a.l); const float sc = l > 0.f ? g_w / l : 0.f;
#pragma unroll
        for (int c = 0; c < 4; ++c) outv[c] += a.o[c] * sc;
    }
    if (!SAMPLE || qi == 0) {
        bf16* od = WSP(bf16, WS_ONSA) + (size_t)rowq * 512 + head * 64 + 4 * fq;
#pragma unroll
        for (int c = 0; c < 4; ++c) { v2u w; w.x = cvtpk(outv[c][0], outv[c][1]); w.y = cvtpk(outv[c][2], outv[c][3]); *(v2u*)(od + 16 * c) = w; }
    }
    WAVE_SYNC();
}

__device__ __forceinline__ void merge_parts(const LAS float* PART, int lane, int slot, float gate, f4 (&outv)[4], float xm, float xl, const f4 (&xo)[4]) {
    float M = xm;
#pragma unroll
    for (int w = 0; w < 8; ++w) M = fmaxf(M, PART[(w * 64 + lane) * 40 + slot]);
    const float xs = fexp2(xm - M);
    float L = xl * xs; f4 o[4];
#pragma unroll
    for (int c = 0; c < 4; ++c) o[c] = xo[c] * xs;
#pragma unroll
    for (int w = 0; w < 8; ++w) { const LAS float* p = PART + (w * 64 + lane) * 40 + slot; const float sc = fexp2(p[0] - M); L += p[1] * sc;
#pragma unroll
        for (int c = 0; c < 4; ++c) o[c] += *(const LAS f4*)(p + 4 + 4 * c) * sc; }
    L = col_total(L); const float s = L > 0.f ? gate / L : 0.f;
#pragma unroll
    for (int c = 0; c < 4; ++c) outv[c] += o[c] * s;
}
__device__ __forceinline__ void nsa_sample_block(Ctx& C, int task) {
    const int lane = C.lane, r = lane & 15, fq = lane >> 4, g = r & 3, w = C.wave;
    const int kvh = task & 1, b = task >> 1, rowq = T + b, head = kvh * 4 + g;
    LAS float* SCs = (LAS float*)(C.lds);
    LAS unsigned* SELMs = (LAS unsigned*)(C.lds + 1024);
    LAS float* EDGE = (LAS float*)(C.lds + 1024 + 64);
    LAS float* PART = (LAS float*)(C.lds + 2048);
    bf16x8 bq[2];
    { const bf16* qp = WSP(bf16, WS_Q) + ((size_t)rowq * 8 + head) * 64 + 8 * fq; bq[0] = *(const bf16x8*)qp; bq[1] = *(const bf16x8*)(qp + 32); }
    const float* gn = WSP(float, WS_GN) + (size_t)rowq * 24 + head * 3;
    const float g_c = gn[0], g_s = gn[1], g_w = gn[2];
    const SrcB csrc{WSP(bf16, WS_CMPKS) + (size_t)(b * 2 + kvh) * 65536, WSP(bf16, WS_CMPVS) + (size_t)(b * 2 + kvh) * 65536, 1024};
    constexpr int NVIS = 1023;
    float m = -1e30f, l = 0.f;
#pragma unroll 2
    for (int i = 0; i < 4; ++i) { const int kb = 32 * (w + 8 * i);
        bf16x8 kf[2][2]; load_k(csrc, kb, lane, kf);
        f4 s0, s1; qk_scores(kf, bq, s0, s1);
        float mx = -1e30f;
#pragma unroll
        for (int j = 0; j < 4; ++j) { mx = fmaxf(mx, (kb + 8 * fq + j < NVIS) ? s0[j] : -1e30f); mx = fmaxf(mx, (kb + 8 * fq + 4 + j < NVIS) ? s1[j] : -1e30f); }
        if (__any(mx > m + MAX_SLACK)) { mx = fmaxf(mx, __shfl_xor(mx, 16)); mx = fmaxf(mx, __shfl_xor(mx, 32)); const float mn = fmaxf(m, mx); l *= fexp2(m - mn); m = mn; }
#pragma unroll
        for (int j = 0; j < 4; ++j) { l += (kb + 8 * fq + j < NVIS) ? fexp2(s0[j] - m) : 0.f; l += (kb + 8 * fq + 4 + j < NVIS) ? fexp2(s1[j] - m) : 0.f; } }
    PART[(w * 64 + lane) * 40 + 0] = m; PART[(w * 64 + lane) * 40 + 1] = l;
    __syncthreads();
    float M = -1e30f, L = 0.f;
#pragma unroll
    for (int ww = 0; ww < 8; ++ww) M = fmaxf(M, PART[(ww * 64 + lane) * 40]);
#pragma unroll
    for (int ww = 0; ww < 8; ++ww) L += PART[(ww * 64 + lane) * 40 + 1] * fexp2(PART[(ww * 64 + lane) * 40] - M);
    L = col_total(L); const float il = L > 0.f ? 1.0f / L : 0.f;
    __syncthreads();
    {
        f4 o[4];
#pragma unroll
        for (int c = 0; c < 4; ++c) o[c] = (f4){0.f, 0.f, 0.f, 0.f};
#pragma unroll 1
        for (int i = 0; i < 4; ++i) { const int kb = 32 * (w + 8 * i);
            bf16x8 kf[2][2], vf[4]; load_k(csrc, kb, lane, kf); load_v(csrc, kb, lane, vf);
            f4 s0, s1; qk_scores(kf, bq, s0, s1);
            f4 p0, p1;
#pragma unroll
            for (int j = 0; j < 4; ++j) { p0[j] = (kb + 8 * fq + j < NVIS) ? fexp2(s0[j] - M) * il : 0.f; p1[j] = (kb + 8 * fq + 4 + j < NVIS) ? fexp2(s1[j] - M) * il : 0.f; }
            const bf16x8 pb = pack8(p0, p1);
#pragma unroll
            for (int c = 0; c < 4; ++c) o[c] = MFMA16(vf[c], pb, o[c]);
            const float tcur = p1[3];
            const float up_same = __shfl(tcur, (lane + 48) & 63);
            float g0 = (p0[0] + p0[1]) + (p0[2] + p0[3]) + (fq ? up_same : 0.f);
            float g1 = (p1[0] + p1[1]) + (p1[2] + p1[3]) + p0[3];
            float ed = tcur;
            g0 += __shfl_xor(g0, 1); g0 += __shfl_xor(g0, 2); g1 += __shfl_xor(g1, 1); g1 += __shfl_xor(g1, 2); ed += __shfl_xor(ed, 1); ed += __shfl_xor(ed, 2);
            const int jb = (kb >> 2) + 2 * fq;
            SCs[jb] = g0; SCs[jb + 1] = g1;
            EDGE[fq == 3 ? (kb >> 5) : 32] = ed;
        }
#pragma unroll
        for (int c = 0; c < 4; ++c) *(LAS f4*)(PART + (w * 64 + lane) * 40 + 4 + 4 * c) = o[c];
    }
    __syncthreads();
    if (w == 0) {
        if (lane >= 1 && lane < 32) SCs[8 * lane] += EDGE[lane - 1];
#pragma unroll
        for (int c = 0; c < 4; ++c) { f4 o = (f4){0.f, 0.f, 0.f, 0.f};
#pragma unroll
            for (int ww = 0; ww < 8; ++ww) o += *(const LAS f4*)(PART + (ww * 64 + lane) * 40 + 4 + 4 * c);
            *(LAS f4*)(C.lds + 86016 + (c * 64 + lane) * 16) = o * g_c; }
        WAVE_SYNC();
        select_blocks(SCs, SELMs, 254, 255, 255, lane);
    }
    __syncthreads();
    AttnAcc as_, aw; attn_init(as_); attn_init(aw);
    {
        int rank = 0;
#pragma unroll 1
        for (int wd = 0; wd < 8; ++wd) { unsigned uw = (unsigned)__builtin_amdgcn_readfirstlane((int)SELMs[wd]);
            while (uw) { const int bit = __builtin_ctz(uw); uw &= uw - 1u; const int blk = 32 * wd + bit;
                if ((rank & 7) == w) {
                    const int phys = ((const int*)C.in[8])[b * 128 + (blk >> 1)];
                    const SrcF src{C.in[5] + ((size_t)phys * 128 + (size_t)(blk & 1) * 64) * 256, kvh * 64, 128 + kvh * 64, 64};
                    attn_range(as_, src, bq, 0, 64, lane, [&](int) { return true; }); }
                ++rank; } }
        const SrcF wsrc{C.out + O_WINS + (size_t)b * 512 * 256, kvh * 64, 128 + kvh * 64, 512};
        attn_range(aw, wsrc, bq, 64 * w, 64 * w + 64, lane, [&](int) { return true; });
    }
    { LAS float* p = PART + (w * 64 + lane) * 40; p[0] = as_.m; p[1] = as_.l; p[20] = aw.m; p[21] = aw.l;
#pragma unroll
      for (int c = 0; c < 4; ++c) { *(LAS f4*)(p + 4 + 4 * c) = as_.o[c]; *(LAS f4*)(p + 24 + 4 * c) = aw.o[c]; } }
    __syncthreads();
    if (w == 0) {
        f4 outv[4];
#pragma unroll
        for (int c = 0; c < 4; ++c) outv[c] = *(const LAS f4*)(C.lds + 86016 + (c * 64 + lane) * 16);
        float xm; f4 xo[4];
        { const bf16* kp = WSP(bf16, WS_KS) + ((size_t)kvh * RP + rowq) * 64 + 8 * fq; const v4u k0 = *(const v4u*)kp, k1 = *(const v4u*)(kp + 32);
          f4 ka, kb2, kc, kd, qa, qb2, qc, qd; bf8_to_f(k0, ka, kb2); bf8_to_f(k1, kc, kd); bf8_to_f(__builtin_bit_cast(v4u, bq[0]), qa, qb2); bf8_to_f(__builtin_bit_cast(v4u, bq[1]), qc, qd);
          const f4 pr = qa * ka + qb2 * kb2 + qc * kc + qd * kd; xm = col_total((pr[0] + pr[1]) + (pr[2] + pr[3]));
          const bf16* vp = WSP(bf16, WS_VST) + ((size_t)kvh * 64 + 4 * fq) * RP + rowq;
#pragma unroll
          for (int c = 0; c < 4; ++c)
#pragma unroll
              for (int j = 0; j < 4; ++j) xo[c][j] = bf2f(vp[(size_t)(16 * c + j) * RP]); }
        const f4 zo[4] = {{0.f, 0.f, 0.f, 0.f}, {0.f, 0.f, 0.f, 0.f}, {0.f, 0.f, 0.f, 0.f}, {0.f, 0.f, 0.f, 0.f}};
        merge_parts(PART, lane, 0, g_s, outv, xm, fq == 0 ? 1.0f : 0.0f, xo); merge_parts(PART, lane, 20, g_w, outv, -1e30f, 0.f, zo);
        if ((r >> 2) == 0) { bf16* od = WSP(bf16, WS_ONSA) + (size_t)rowq * 512 + head * 64 + 4 * fq;
#pragma unroll
            for (int c = 0; c < 4; ++c) { v2u wv; wv.x = cvtpk(outv[c][0], outv[c][1]); wv.y = cvtpk(outv[c][2], outv[c][3]); *(v2u*)(od + 16 * c) = wv; } }
    }
    __syncthreads();
}

struct TileSrc { const bf16* K; const bf16* VT; int pitch; };
__device__ __forceinline__ void tile_fetch(const TileSrc& s, int kb, int tid, v4u& rk, v4u& rv) {
    const int row = tid >> 3, c = tid & 7;
    rk = *(const v4u*)(s.K + (size_t)(kb + row) * 64 + 8 * c);
    rv = *(const v4u*)(s.VT + (size_t)row * s.pitch + kb + 8 * c);
}
__device__ __forceinline__ void tile_store(LAS unsigned char* buf, int tid, const v4u& rk, const v4u& rv) {
    const int row = tid >> 3, c = tid & 7;
    const int kap = row & 31, rho = (row & 32) + 16 * ((kap >> 2) & 1) + 4 * (kap >> 3) + (kap & 3);
    *(LAS v4u*)(buf + rho * 128 + 16 * (c ^ ((rho >> 1) & 7))) = rk;
    *(LAS v4u*)(buf + 8192 + row * 128 + 16 * (c ^ ((row >> 1) & 7))) = rv;
}
__device__ __forceinline__ void tile_read_k(const LAS unsigned char* buf, int ch, int lane, bf16x8 (&kf)[2][2]) {
    const int r = lane & 15, fq = lane >> 4;
#pragma unroll
    for (int kt = 0; kt < 2; ++kt) { const int rho = 32 * ch + 16 * kt + r;
#pragma unroll
        for (int s = 0; s < 2; ++s) kf[kt][s] = *(const LAS bf16x8*)(buf + rho * 128 + 16 * ((4 * s + fq) ^ ((rho >> 1) & 7))); }
}
__device__ __forceinline__ void tile_read_v(const LAS unsigned char* buf, int ch, int lane, bf16x8 (&vf)[4]) {
    const int r = lane & 15, fq = lane >> 4;
#pragma unroll
    for (int cc = 0; cc < 4; ++cc) { const int d = 16 * cc + r; vf[cc] = *(const LAS bf16x8*)(buf + 8192 + d * 128 + 16 * ((4 * ch + fq) ^ ((d >> 1) & 7))); }
}
template <int STG, class F>
__device__ __forceinline__ void stream_tiles(Ctx& C, const TileSrc& src, int tile0, int ntiles, LAS unsigned char* bufs, F&& compute) {
    if (ntiles <= 0) return;
    const int nst = (ntiles + STG - 1) / STG, tlast = tile0 + ntiles - 1;
    v4u rk[STG], rv[STG];
    { const int tidl = launder_v(C.tid);
#pragma unroll
      for (int h = 0; h < STG; ++h) { const int t = tile0 + h; tile_fetch(src, 64 * (t < tlast ? t : tlast), tidl, rk[h], rv[h]); }
#pragma unroll
      for (int h = 0; h < STG; ++h) tile_store(bufs + h * 16384, tidl, rk[h], rv[h]); }
    __syncthreads();
#pragma unroll 1
    for (int st = 0; st < nst; ++st) {
        const int tidl = launder_v(C.tid);
        const bool more = st + 1 < nst;
        if (more) {
#pragma unroll
            for (int h = 0; h < STG; ++h) { const int t = tile0 + STG * (st + 1) + h; tile_fetch(src, 64 * (t < tlast ? t : tlast), tidl, rk[h], rv[h]); } }
        LAS unsigned char* cur = bufs + (st & 1) * (STG * 16384);
#pragma unroll 1
        for (int h = 0; h < STG; ++h) if (STG * st + h < ntiles) compute(cur + h * 16384, tile0 + STG * st + h);
        if (more) {
#pragma unroll
            for (int h = 0; h < STG; ++h) tile_store(bufs + ((st + 1) & 1) * (STG * 16384) + h * 16384, tidl, rk[h], rv[h]); }
        __syncthreads();
    }
}
__device__ __forceinline__ void nsa_block_task(Ctx& C, int task, bf16* ONSA_OUT) {
    const int lane = C.lane, r = lane & 15, fq = lane >> 4, qi = r >> 2, g = r & 3, w = C.wave;
    const int kvh = task >= 256 ? 1 : 0, qb = task >= 256 ? 511 - task : task, t0 = 64 * qb;
    LAS unsigned char* bufs = C.lds;
    LAS float* SC = (LAS float*)(C.lds + 65536 + w * 8448);
    LAS unsigned* SELM = (LAS unsigned*)(C.lds + 133120 + w * 256);
    const int head = kvh * 4 + g;
    int tl[2]; bf16x8 bq[2][2]; float g_c[2], g_s[2], g_w[2];
#pragma unroll
    for (int cg = 0; cg < 2; ++cg) { tl[cg] = t0 + 8 * w + 4 * cg + qi;
        const bf16* qp = WSP(bf16, WS_Q) + ((size_t)tl[cg] * 8 + head) * 64 + 8 * fq; bq[cg][0] = *(const bf16x8*)qp; bq[cg][1] = *(const bf16x8*)(qp + 32);
        const float* gn = WSP(float, WS_GN) + (size_t)tl[cg] * 24 + head * 3; g_c[cg] = gn[0]; g_s[cg] = gn[1]; g_w[cg] = gn[2]; }
    f4 oc[2][4];
    {
        const int kvc = launder_s(kvh);
        const TileSrc src{WSP(bf16, WS_CMPKP) + (size_t)kvc * 65536, WSP(bf16, WS_CMPVP) + (size_t)kvc * 65536, 1024};
        int nvis[2];
#pragma unroll
        for (int cg = 0; cg < 2; ++cg) nvis[cg] = tl[cg] >= 31 ? ((tl[cg] - 31) >> 4) + 1 : 0;
        const int twmax = t0 + 8 * w + 7; const int nvw = twmax >= 31 ? ((twmax - 31) >> 4) + 1 : 0;
        const int nvb = ((t0 + 63 - 31) >> 4) + 1;
        const int ntile = (nvb + 63) >> 6;
        float m[2] = {-1e30f, -1e30f}, l[2] = {0.f, 0.f};
        stream_tiles<2>(C, src, 0, ntile, bufs, [&](const LAS unsigned char* buf, int j) {
#pragma unroll
            for (int ch = 0; ch < 2; ++ch) { const int kb = 64 * j + 32 * ch; if (kb >= nvw) continue;
                bf16x8 kf[2][2]; tile_read_k(buf, ch, launder_v(lane), kf);
#pragma unroll
                for (int cg = 0; cg < 2; ++cg) {
                    f4 s0, s1;
#pragma unroll
                    for (int jj = 0; jj < 4; ++jj) { s0[jj] = (kb + 8 * fq + jj < nvis[cg]) ? 0.f : -3e30f; s1[jj] = (kb + 8 * fq + 4 + jj < nvis[cg]) ? 0.f : -3e30f; }
                    s0 = MFMA16(kf[0][0], bq[cg][0], s0); s0 = MFMA16(kf[0][1], bq[cg][1], s0); s1 = MFMA16(kf[1][0], bq[cg][0], s1); s1 = MFMA16(kf[1][1], bq[cg][1], s1);
                    float mx = fmaxf(fmaxf(fmaxf(s0[0], s0[1]), fmaxf(s0[2], s0[3])), fmaxf(fmaxf(s1[0], s1[1]), fmaxf(s1[2], s1[3])));
                    if (__any(mx > m[cg] + MAX_SLACK)) { mx = fmaxf(mx, __shfl_xor(mx, 16)); mx = fmaxf(mx, __shfl_xor(mx, 32));
                        const float mn = fmaxf(m[cg], mx); l[cg] *= fexp2(m[cg] - mn); m[cg] = mn; }
                    float ps = 0.f;
#pragma unroll
                    for (int jj = 0; jj < 4; ++jj) ps += fexp2(s0[jj] - m[cg]) + fexp2(s1[jj] - m[cg]);
                    l[cg] += ps;
                } }
        });
        float il[2];
#pragma unroll
        for (int cg = 0; cg < 2; ++cg) { const float lt = col_total(l[cg]); il[cg] = lt > 0.f ? 1.0f / lt : 0.f; }
#pragma unroll
        for (int i = 0; i < 32; ++i) SC[lane * 32 + i] = 0.f;
        WAVE_SYNC();
        f4 o[2][4];
#pragma unroll
        for (int cg = 0; cg < 2; ++cg)
#pragma unroll
            for (int c = 0; c < 4; ++c) o[cg][c] = (f4){0.f, 0.f, 0.f, 0.f};
        float tprev[2] = {0.f, 0.f};
        stream_tiles<2>(C, src, 0, ntile, bufs, [&](const LAS unsigned char* buf, int j) {
#pragma unroll
            for (int ch = 0; ch < 2; ++ch) { const int kb = 64 * j + 32 * ch; if (kb >= nvw) continue;
                const int ll = launder_v(lane), fq2 = ll >> 4, qi2 = (ll >> 2) & 3;
                bf16x8 kf[2][2], vf[4]; { tile_read_k(buf, ch, ll, kf); tile_read_v(buf, ch, ll, vf); }
#pragma unroll
                for (int cg = 0; cg < 2; ++cg) {
                    f4 s0, s1;
#pragma unroll
                    for (int jj = 0; jj < 4; ++jj) { s0[jj] = (kb + 8 * fq + jj < nvis[cg]) ? 0.f : -3e30f; s1[jj] = (kb + 8 * fq + 4 + jj < nvis[cg]) ? 0.f : -3e30f; }
                    s0 = MFMA16(kf[0][0], bq[cg][0], s0); s0 = MFMA16(kf[0][1], bq[cg][1], s0); s1 = MFMA16(kf[1][0], bq[cg][0], s1); s1 = MFMA16(kf[1][1], bq[cg][1], s1);
                    f4 p0, p1;
#pragma unroll
                    for (int jj = 0; jj < 4; ++jj) { p0[jj] = fexp2(s0[jj] - m[cg]) * il[cg]; p1[jj] = fexp2(s1[jj] - m[cg]) * il[cg]; }
                    const bf16x8 pb = pack8(p0, p1);
#pragma unroll
                    for (int c = 0; c < 4; ++c) o[cg][c] = MFMA16(vf[c], pb, o[cg][c]);
                    const float tcur = p1[3];
                    const float up_same = __shfl(tcur, (ll + 48) & 63), up_prev = __shfl(tprev[cg], (ll + 48) & 63);
                    tprev[cg] = tcur;
                    float g0 = (p0[0] + p0[1]) + (p0[2] + p0[3]) + (fq2 ? up_same : up_prev);
                    float g1 = (p1[0] + p1[1]) + (p1[2] + p1[3]) + p0[3];
                    g0 += __shfl_xor(g0, 1); g0 += __shfl_xor(g0, 2); g1 += __shfl_xor(g1, 1); g1 += __shfl_xor(g1, 2);
                    { const int jb = (kb >> 2) + 2 * fq2; SC[(4 * cg + qi2) * 256 + jb] = g0; SC[(4 * cg + qi2) * 256 + jb + 1] = g1; }
                } }
        });
#pragma unroll
        for (int cg = 0; cg < 2; ++cg)
#pragma unroll
            for (int c = 0; c < 4; ++c) oc[cg][c] = o[cg][c] * g_c[cg];
    }
    WAVE_SYNC();
    {
#pragma unroll 1
        for (int q = 0; q < 8; ++q) {
            if (qb < 16) { if (lane < 8) SELM[q * 8 + lane] = (lane == 0) ? ((1u << (qb + 1)) - 1u) : 0u; }
            else select_blocks(SC + q * 256, SELM + q * 8, qb - 2, qb, qb - 1, lane);
        }
    }
    WAVE_SYNC();
    LAS unsigned* ANYM = (LAS unsigned*)(C.lds + 135168 + w * 64);
    { const int la = launder_v(lane); if (la < 16) { const int cgx = la >> 3, w8 = la & 7; ANYM[la] = SELM[(4 * cgx + 0) * 8 + w8] | SELM[(4 * cgx + 1) * 8 + w8] | SELM[(4 * cgx + 2) * 8 + w8] | SELM[(4 * cgx + 3) * 8 + w8]; } }
    WAVE_SYNC();
    f4* STASH = WSP(f4, WS_STASH) + (size_t)(C.bid * NWAVES + w) * 512;
#pragma unroll
    for (int cg = 0; cg < 2; ++cg)
#pragma unroll
        for (int c = 0; c < 4; ++c) STASH[(cg * 4 + c) * 64 + lane] = oc[cg][c];
    __syncthreads();
    {
        AttnAcc a[2]; attn_init(a[0]); attn_init(a[1]);
        const int kvs = launder_s(kvh);
        const TileSrc src{WSP(bf16, WS_KS) + (size_t)kvs * RP * 64, WSP(bf16, WS_VST) + (size_t)kvs * 64 * RP, RP};
        int cw = -1; unsigned aw0 = 0u, aw1 = 0u;
        stream_tiles<4>(C, src, 0, qb, bufs, [&](const LAS unsigned char* buf, int j) {
            if ((j >> 5) != cw) { cw = j >> 5; aw0 = (unsigned)__builtin_amdgcn_readfirstlane((int)ANYM[cw]); aw1 = (unsigned)__builtin_amdgcn_readfirstlane((int)ANYM[8 + cw]); }
            bool any[2]; any[0] = (aw0 >> (j & 31)) & 1u; any[1] = (aw1 >> (j & 31)) & 1u;
            if (any[0] || any[1]) {
                bool mysel[2];
#pragma unroll
                for (int cg = 0; cg < 2; ++cg) mysel[cg] = (SELM[(4 * cg + qi) * 8 + (j >> 5)] >> (j & 31)) & 1u;
                bf16x8 kf[2][2][2], vf[2][4]; { const int ll = launder_v(lane);
#pragma unroll
                    for (int ch = 0; ch < 2; ++ch) { tile_read_k(buf, ch, ll, kf[ch]); tile_read_v(buf, ch, ll, vf[ch]); } }
#pragma unroll
                for (int cg = 0; cg < 2; ++cg) if (any[cg]) attn_tile64_full(a[cg], kf, vf, bq[cg], mysel[cg] ? 0.f : -3e30f);
            }
        });
        stream_tiles<1>(C, src, qb, 1, bufs, [&](const LAS unsigned char* buf, int j) {
            bf16x8 kf[2][2][2], vf[2][4]; { const int ll = launder_v(lane);
#pragma unroll
                for (int ch = 0; ch < 2; ++ch) { tile_read_k(buf, ch, ll, kf[ch]); tile_read_v(buf, ch, ll, vf[ch]); } }
#pragma unroll
            for (int cg = 0; cg < 2; ++cg) { const int tq = tl[cg];
                attn_tile64(a[cg], kf, vf, bq[cg], 64 * j, fq, [&](int key) { return key <= tq; }); }
        });
#pragma unroll
        for (int cg = 0; cg < 2; ++cg) { const float lt = col_total(a[cg].l); const float sc = lt > 0.f ? g_s[cg] / lt : 0.f;
#pragma unroll
            for (int c = 0; c < 4; ++c) STASH[(cg * 4 + c) * 64 + lane] += a[cg].o[c] * sc; }
    }
    {
        AttnAcc a[2]; attn_init(a[0]); attn_init(a[1]);
        const int kvw = launder_s(kvh);
        const TileSrc src{WSP(bf16, WS_KW) + (size_t)kvw * RP * 64, WSP(bf16, WS_VWT) + (size_t)kvw * 64 * RP, RP};
        const int j0 = qb > 8 ? qb - 8 : 0;
        const int twmin = t0 + 8 * w, twmax = twmin + 7;
        stream_tiles<4>(C, src, j0, qb + 1 - j0, bufs, [&](const LAS unsigned char* buf, int j) {
            const int kb = 64 * j;
            if (kb > twmax || kb + 63 <= twmin - 512) return;
            bf16x8 kf[2][2][2], vf[2][4]; { const int ll = launder_v(lane);
#pragma unroll
                for (int ch = 0; ch < 2; ++ch) { tile_read_k(buf, ch, ll, kf[ch]); tile_read_v(buf, ch, ll, vf[ch]); } }
            const bool interior = (kb + 63 <= twmin) && (kb > twmax - 512);
#pragma unroll
            for (int cg = 0; cg < 2; ++cg) { const int tq = tl[cg];
                if (interior) attn_tile64_full(a[cg], kf, vf, bq[cg]);
                else attn_tile64(a[cg], kf, vf, bq[cg], kb, fq, [&](int key) { return key <= tq && key > tq - 512; }); }
        });
#pragma unroll
        for (int cg = 0; cg < 2; ++cg) { const float lt = col_total(a[cg].l); const float sc = lt > 0.f ? g_w[cg] / lt : 0.f;
        bf16* od = ONSA_OUT + (size_t)tl[cg] * 512 + head * 64 + 4 * fq;
#pragma unroll
            for (int c = 0; c < 4; ++c) { const f4 ov = STASH[(cg * 4 + c) * 64 + lane] + a[cg].o[c] * sc;
                v2u wv; wv.x = cvtpk(ov[0], ov[1]); wv.y = cvtpk(ov[2], ov[3]); *(v2u*)(od + 16 * c) = wv; } }
    }
    __syncthreads();
}

__device__ __forceinline__ void ret_u_task(Ctx& C, int task) {
    const int lane = C.lane, r = lane & 15, fq = lane >> 4;
    const int eq = task & 3, h = (task >> 2) & 3, c = task >> 4;
    const bf16* VT = WSP(bf16, WS_RVT) + ((size_t)(h * 256 + 64 * eq + r)) * RP + 128 * c + 8 * fq;
    const bf16* KT = WSP(bf16, WS_RKIT) + ((size_t)(h * 128 + r)) * RP + 128 * c + 8 * fq;
    f4 acc[4][8];
#pragma unroll
    for (int et = 0; et < 4; ++et)
#pragma unroll
        for (int dt = 0; dt < 8; ++dt) acc[et][dt] = (f4){0.f, 0.f, 0.f, 0.f};
#pragma unroll 1
    for (int s2 = 0; s2 < 4; s2 += 2) {
        bf16x8 a[2][4], bb[2][8];
#pragma unroll
        for (int u2 = 0; u2 < 2; ++u2) {
#pragma unroll
            for (int et = 0; et < 4; ++et) a[u2][et] = *(const bf16x8*)(VT + (size_t)(16 * et) * RP + 32 * (s2 + u2));
#pragma unroll
            for (int dt = 0; dt < 8; ++dt) bb[u2][dt] = *(const bf16x8*)(KT + (size_t)(16 * dt) * RP + 32 * (s2 + u2)); }
#pragma unroll
        for (int u2 = 0; u2 < 2; ++u2)
#pragma unroll
            for (int et = 0; et < 4; ++et)
#pragma unroll
                for (int dt = 0; dt < 8; ++dt) acc[et][dt] = MFMA16(bb[u2][dt], a[u2][et], acc[et][dt]);
    }
#if 0
    for (int s = 0; s < 4; ++s) {
        bf16x8 a[4], bb[8];
#pragma unroll
        for (int et = 0; et < 4; ++et) a[et] = *(const bf16x8*)(VT + (size_t)(16 * et) * RP + 32 * s);
#pragma unroll
        for (int dt = 0; dt < 8; ++dt) bb[dt] = *(const bf16x8*)(KT + (size_t)(16 * dt) * RP + 32 * s);
#pragma unroll
        for (int et = 0; et < 4; ++et)
#pragma unroll
            for (int dt = 0; dt < 8; ++dt) acc[et][dt] = MFMA16(bb[dt], a[et], acc[et][dt]);
    }
#endif
    float* U = WSP(float, WS_U) + ((size_t)(c * 4 + h) * 256 + 64 * eq) * 128;
#pragma unroll
    for (int et = 0; et < 4; ++et)
#pragma unroll
        for (int dt = 0; dt < 8; ++dt)
            *(f4*)(U + (size_t)(16 * et + r) * 128 + 16 * dt + 4 * fq) = acc[et][dt];
}
__device__ __forceinline__ void ret_scan(Ctx& C, int nsb) {
    const float* U = WSP(float, WS_U); bf16* SP = WSP(bf16, WS_SPREV); const float* gp = WSP(float, WS_GPOW);
    for (int idx0 = C.bid * 512 + C.tid; idx0 < 32768; idx0 += nsb * 512) {
        const int e = (idx0 >> 7) & 255, d = idx0 & 127;
        float g128[4], S[4];
#pragma unroll
        for (int j = 0; j < 4; ++j) { g128[j] = gp[j * 132 + 128]; S[j] = 0.f; }
#pragma unroll 1
        for (int c0 = 0; c0 < 128; c0 += 16) {
            float u[4][16];
#pragma unroll
            for (int k = 0; k < 16; ++k)
#pragma unroll
                for (int j = 0; j < 4; ++j) u[j][k] = __builtin_nontemporal_load(U + (size_t)(c0 + k) * 131072 + j * 32768 + idx0);
#pragma unroll
            for (int k = 0; k < 16; ++k)
#pragma unroll
                for (int j = 0; j < 4; ++j) { SP[(size_t)(c0 + k) * 131072 + j * 32768 + idx0] = bf1(S[j]); S[j] = g128[j] * (S[j] + u[j][k]); }
        }
#pragma unroll
        for (int j = 0; j < 4; ++j) C.out[O_STP + ((size_t)j * 128 + d) * 256 + e] = S[j];
    }
}
__device__ __forceinline__ void ret_out_task(Ctx& C, int task) {
    const int lane = C.lane, r = lane & 15, fq = lane >> 4;
    const int ig2 = task & 3, h = (task >> 2) & 3, c = task >> 4;
    const int i0 = 128 * c + 32 * ig2;
    bf16x8 bq[2][4];
#pragma unroll
    for (int g = 0; g < 2; ++g) { const bf16* qp = WSP(bf16, WS_RQD) + ((size_t)(i0 + 16 * g + r) * 4 + h) * 128 + 8 * fq;
#pragma unroll
        for (int s = 0; s < 4; ++s) bq[g][s] = *(const bf16x8*)(qp + 32 * s); }
    f4 o[2][16];
#pragma unroll
    for (int g = 0; g < 2; ++g)
#pragma unroll
        for (int et = 0; et < 16; ++et) o[g][et] = (f4){0.f, 0.f, 0.f, 0.f};
    { const bf16* sp = WSP(bf16, WS_SPREV) + ((size_t)(c * 4 + h) * 256 + r) * 128 + 8 * fq;
#pragma unroll
      for (int et = 0; et < 16; ++et) { bf16x8 a[4];
#pragma unroll
          for (int s = 0; s < 4; ++s) a[s] = *(const bf16x8*)(sp + (size_t)(16 * et) * 128 + 32 * s);
#pragma unroll
          for (int s = 0; s < 4; ++s) { o[0][et] = MFMA16(a[s], bq[0][s], o[0][et]); o[1][et] = MFMA16(a[s], bq[1][s], o[1][et]); } } }
#pragma unroll 1
    for (int jc = 0; jc <= ig2; ++jc) {
        bf16x8 kf[2][4];
#pragma unroll
        for (int kt = 0; kt < 2; ++kt) { const bf16* kp = WSP(bf16, WS_RKI) + ((size_t)(128 * c + 32 * jc + 8 * (r >> 2) + 4 * kt + (r & 3)) * 4 + h) * 128 + 8 * fq;
#pragma unroll
            for (int s = 0; s < 4; ++s) kf[kt][s] = *(const bf16x8*)(kp + 32 * s); }
        bf16x8 pb[2];
#pragma unroll
        for (int g = 0; g < 2; ++g) { f4 s0 = (f4){0.f, 0.f, 0.f, 0.f}, s1 = s0;
#pragma unroll
            for (int s = 0; s < 4; ++s) { s0 = MFMA16(kf[0][s], bq[g][s], s0); s1 = MFMA16(kf[1][s], bq[g][s], s1); }
            const int i = 32 * ig2 + 16 * g + r;
#pragma unroll
            for (int j = 0; j < 4; ++j) { s0[j] = (32 * jc + 8 * fq + j > i) ? 0.f : s0[j]; s1[j] = (32 * jc + 8 * fq + 4 + j > i) ? 0.f : s1[j]; }
            pb[g] = pack8(s0, s1); }
        const bf16* vp = WSP(bf16, WS_RVT) + ((size_t)(h * 256 + r)) * RP + 128 * c + 32 * jc + 8 * fq;
#pragma unroll
        for (int et = 0; et < 16; ++et) { const bf16x8 a = *(const bf16x8*)(vp + (size_t)(16 * et) * RP); o[0][et] = MFMA16(a, pb[0], o[0][et]); o[1][et] = MFMA16(a, pb[1], o[1][et]); }
    }
    const float* gw = C.in[17] + h * 256 + 4 * fq; const float* gb = C.in[18] + h * 256 + 4 * fq;
#pragma unroll
    for (int g = 0; g < 2; ++g) {
        float sm = 0.f;
#pragma unroll
        for (int et = 0; et < 16; ++et) sm += (o[g][et][0] + o[g][et][1]) + (o[g][et][2] + o[g][et][3]);
        sm = col_total(sm); const float mu = sm * (1.0f / 256.0f);
        float q = 0.f;
#pragma unroll
        for (int et = 0; et < 16; ++et) { const f4 dlt = o[g][et] - mu; q += (dlt[0] * dlt[0] + dlt[1] * dlt[1]) + (dlt[2] * dlt[2] + dlt[3] * dlt[3]); }
        q = col_total(q); const float rstd = 1.0f / sqrtf(q * (1.0f / 256.0f) + 1e-5f);
        const size_t ro = (size_t)(i0 + 16 * g + r) * 1024 + h * 256 + 4 * fq;
#pragma unroll
        for (int et = 0; et < 16; ++et) {
            const f4 y = (o[g][et] - mu) * rstd * *(const f4*)(gw + 16 * et) + *(const f4*)(gb + 16 * et);
            const v2u sg = *(const v2u*)(WSP(bf16, WS_SRG) + ro + 16 * et);
            const float z0 = y[0] * __builtin_bit_cast(float, sg.x << 16), z1 = y[1] * __builtin_bit_cast(float, sg.x & 0xffff0000u),
                        z2 = y[2] * __builtin_bit_cast(float, sg.y << 16), z3 = y[3] * __builtin_bit_cast(float, sg.y & 0xffff0000u);
            v2u w; w.x = cvtpk(z0, z1); w.y = cvtpk(z2, z3); *(v2u*)(WSP(bf16, WS_YRET) + ro + 16 * et) = w;
        }
    }
}
__device__ __forceinline__ void ret_out_block(Ctx& C, int bt) {
    const int lane = C.lane, r = lane & 15, fq = lane >> 4, w = C.wave;
    const int h = bt & 3, c = bt >> 2, i0 = 128 * c + 16 * w;
    LAS unsigned char* SP = C.lds;
    LAS unsigned char* KI = C.lds + 65536;
    const int l4 = launder_v(lane), rsub = l4 >> 4, pc = l4 & 15;
    { const char* sp = (const char*)(WSP(bf16, WS_SPREV) + (size_t)(c * 4 + h) * 256 * 128);
#pragma unroll
      for (int i = 0; i < 8; ++i) { const int q = w + 8 * i, row = 4 * q + rsub;
          __builtin_amdgcn_global_load_lds((const unsigned*)(sp + row * 256 + 16 * (pc ^ (row & 15))), (LAS unsigned*)(SP + q * 1024), 16, 0, 0); }
      const char* kp = (const char*)(WSP(bf16, WS_RKI) + ((size_t)(128 * c) * 4 + h) * 128);
#pragma unroll
      for (int i = 0; i < 4; ++i) { const int q = w + 8 * i, row = 4 * q + rsub, f = (row & 3) | (((row >> 3) & 3) << 2);
          __builtin_amdgcn_global_load_lds((const unsigned*)(kp + (size_t)row * 1024 + 16 * (pc ^ f)), (LAS unsigned*)(KI + q * 1024), 16, 0, 0); } }
    bf16x8 bq[4];
    { const bf16* qp = WSP(bf16, WS_RQD) + ((size_t)(i0 + r) * 4 + h) * 128 + 8 * fq;
#pragma unroll
      for (int s = 0; s < 4; ++s) bq[s] = *(const bf16x8*)(qp + 32 * s); }
    const size_t ro = (size_t)(i0 + r) * 1024 + h * 256 + 4 * fq;
    v2u sg[16];
#pragma unroll
    for (int et = 0; et < 16; ++et) sg[et] = *(const v2u*)(WSP(bf16, WS_SRG) + ro + 16 * et);
    asm volatile("s_waitcnt vmcnt(0)" ::: "memory");
    __syncthreads();
    f4 o[16];
#pragma unroll
    for (int et = 0; et < 16; ++et) { o[et] = (f4){0.f, 0.f, 0.f, 0.f};
#pragma unroll
        for (int s = 0; s < 4; ++s) { const bf16x8 a = *(const LAS bf16x8*)(SP + (16 * et + r) * 256 + 16 * ((4 * s + fq) ^ r)); o[et] = MFMA16(a, bq[s], o[et]); } }
    const int njc = (w >> 1) + 1;
    bf16x8 pb[4];
#pragma unroll
    for (int jc = 0; jc < 4; ++jc) {
        f4 s0 = (f4){0.f, 0.f, 0.f, 0.f}, s1 = s0;
        if (jc < njc) {
#pragma unroll
            for (int kt = 0; kt < 2; ++kt) { const int kk = 32 * jc + 8 * (r >> 2) + 4 * kt + (r & 3);
#pragma unroll
                for (int s = 0; s < 4; ++s) { const bf16x8 kf = *(const LAS bf16x8*)(KI + kk * 256 + 16 * ((4 * s + fq) ^ r));
                    if (kt == 0) s0 = MFMA16(kf, bq[s], s0); else s1 = MFMA16(kf, bq[s], s1); } }
            const int i = 16 * w + r;
#pragma unroll
            for (int j = 0; j < 4; ++j) { s0[j] = (32 * jc + 8 * fq + j > i) ? 0.f : s0[j]; s1[j] = (32 * jc + 8 * fq + 4 + j > i) ? 0.f : s1[j]; }
        }
        pb[jc] = pack8(s0, s1);
    }
    __syncthreads();
    { const char* vp = (const char*)(WSP(bf16, WS_RVT) + (size_t)(h * 256) * RP + 128 * c);
#pragma unroll
      for (int i = 0; i < 8; ++i) { const int q = w + 8 * i, row = 4 * q + rsub;
          __builtin_amdgcn_global_load_lds((const unsigned*)(vp + (size_t)row * (RP * 2) + 16 * (pc ^ (row & 15))), (LAS unsigned*)(SP + q * 1024), 16, 0, 0); } }
    asm volatile("s_waitcnt vmcnt(0)" ::: "memory");
    __syncthreads();
#pragma unroll
    for (int jc = 0; jc < 4; ++jc)
        if (jc < njc) {
#pragma unroll
            for (int et = 0; et < 16; ++et) { const bf16x8 a = *(const LAS bf16x8*)(SP + (16 * et + r) * 256 + 16 * ((4 * jc + fq) ^ r)); o[et] = MFMA16(a, pb[jc], o[et]); } }
    const float* gw = C.in[17] + h * 256 + 4 * fq; const float* gb = C.in[18] + h * 256 + 4 * fq;
    float sm = 0.f;
#pragma unroll
    for (int et = 0; et < 16; ++et) sm += (o[et][0] + o[et][1]) + (o[et][2] + o[et][3]);
    sm = col_total(sm); const float mu = sm * (1.0f / 256.0f);
    float qv = 0.f;
#pragma unroll
    for (int et = 0; et < 16; ++et) { const f4 dlt = o[et] - mu; qv += (dlt[0] * dlt[0] + dlt[1] * dlt[1]) + (dlt[2] * dlt[2] + dlt[3] * dlt[3]); }
    qv = col_total(qv); const float rstd = 1.0f / sqrtf(qv * (1.0f / 256.0f) + 1e-5f);
#pragma unroll
    for (int hb = 0; hb < 2; ++hb) {
        f4 gwv[8], gbv[8];
#pragma unroll
        for (int e8 = 0; e8 < 8; ++e8) { gwv[e8] = *(const f4*)(gw + 16 * (8 * hb + e8)); gbv[e8] = *(const f4*)(gb + 16 * (8 * hb + e8)); }
#pragma unroll
        for (int e8 = 0; e8 < 8; ++e8) { const int et = 8 * hb + e8;
            const f4 y = (o[et] - mu) * rstd * gwv[e8] + gbv[e8];
            const float z0 = y[0] * __builtin_bit_cast(float, sg[et].x << 16), z1 = y[1] * __builtin_bit_cast(float, sg[et].x & 0xffff0000u),
                        z2 = y[2] * __builtin_bit_cast(float, sg[et].y << 16), z3 = y[3] * __builtin_bit_cast(float, sg[et].y & 0xffff0000u);
            v2u wv; wv.x = cvtpk(z0, z1); wv.y = cvtpk(z2, z3); *(v2u*)(WSP(bf16, WS_YRET) + ro + 16 * et) = wv; }
    }
    __syncthreads();
}
__device__ __forceinline__ void ret_sample_task(Ctx& C, int task) {
    const int b = task >> 2, h = task & 3, row = T + b, lane = C.lane, w = C.wave;
    LAS float* red = (LAS float*)C.lds;
    const bf16* qp = WSP(bf16, WS_RQD) + ((size_t)row * 4 + h) * 128; const bf16* kp = WSP(bf16, WS_RKI) + ((size_t)row * 4 + h) * 128;
    const float gam = WSP(float, WS_GPOW)[h * 132 + 1];
    float qk = bf2f(qp[lane]) * bf2f(kp[lane]) + bf2f(qp[lane + 64]) * bf2f(kp[lane + 64]); qk = wave_sum(qk);
    f4 v4;
#pragma unroll
    for (int j = 0; j < 4; ++j) v4[j] = bf2f(WSP(bf16, WS_RVT)[((size_t)(h * 256 + 4 * lane + j)) * RP + row]);
    f4 po = (f4){0.f, 0.f, 0.f, 0.f};
    const float* S = C.in[7] + ((size_t)(b * 4 + h) * 128) * 256; float* Sn = C.out + O_STS + ((size_t)(b * 4 + h) * 128) * 256;
    { f4 sv[16]; float qd[16], kd[16];
#pragma unroll
      for (int dd = 0; dd < 16; ++dd) { const int d = 16 * w + dd; sv[dd] = __builtin_nontemporal_load((const f4*)(S + (size_t)d * 256) + lane); qd[dd] = bf2f(qp[d]); kd[dd] = bf2f(kp[d]); }
#pragma unroll
      for (int dd = 0; dd < 16; ++dd) { const int d = 16 * w + dd;
          po += sv[dd] * qd[dd]; __builtin_nontemporal_store(sv[dd] * gam + v4 * kd[dd], (f4*)(Sn + (size_t)d * 256) + lane); } }
    *((LAS f4*)(red + w * 256) + lane) = po;
    __syncthreads();
    if (w == 0) {
        f4 o = (f4){0.f, 0.f, 0.f, 0.f};
#pragma unroll
        for (int ww = 0; ww < 8; ++ww) o += *((LAS f4*)(red + ww * 256) + lane);
        o = v4 * qk + o * gam;
        const float mu = wave_sum((o[0] + o[1]) + (o[2] + o[3])) * (1.0f / 256.0f);
        const f4 dl = o - mu; const float var = wave_sum((dl[0] * dl[0] + dl[1] * dl[1]) + (dl[2] * dl[2] + dl[3] * dl[3])) * (1.0f / 256.0f);
        const float rstd = 1.0f / sqrtf(var + 1e-5f);
        const f4 y = dl * rstd * *(const f4*)(C.in[17] + h * 256 + 4 * lane) + *(const f4*)(C.in[18] + h * 256 + 4 * lane);
        const size_t ro = (size_t)row * 1024 + h * 256 + 4 * lane;
        const v2u sg = *(const v2u*)(WSP(bf16, WS_SRG) + ro);
        v2u wv; wv.x = cvtpk(y[0] * __builtin_bit_cast(float, sg.x << 16), y[1] * __builtin_bit_cast(float, sg.x & 0xffff0000u));
        wv.y = cvtpk(y[2] * __builtin_bit_cast(float, sg.y << 16), y[3] * __builtin_bit_cast(float, sg.y & 0xffff0000u));
        *(v2u*)(WSP(bf16, WS_YRET) + ro) = wv;
    }
    __syncthreads();
}

#define XB_TMO      128
#define XB_XCNT(j)  (256  + 64 * (j))
#define XB_XSUB(j)  (1280 + 64 * (j))
#define XB_XGEN(j)  (2304 + 64 * (j))
#define XB_TOP      3328
#define XB_TOPGEN   3392
#define XCD_BAR_WORDS 3456
#define XB_SPIN_CAP (1u << 18)

__device__ __forceinline__ unsigned xb_ld(unsigned* p)              { return __hip_atomic_load(p, __ATOMIC_RELAXED, __HIP_MEMORY_SCOPE_AGENT); }
__device__ __forceinline__ unsigned xb_add(unsigned* p, unsigned v) { return __hip_atomic_fetch_add(p, v, __ATOMIC_RELAXED, __HIP_MEMORY_SCOPE_AGENT); }
__device__ __forceinline__ unsigned xb_xcc_id() { return (unsigned)__builtin_amdgcn_s_getreg((3 << 11) | 20) & 0xFu; }
#define XB_SPIN(cond, bar) do { unsigned _sp = 0; while (cond) { __builtin_amdgcn_s_sleep(1); \
    if ((++_sp & 255u) == 0u) { if (xb_ld(&(bar)[XB_TMO])) break; if (_sp > XB_SPIN_CAP) { atomicAdd(&(bar)[XB_TMO], 1u); break; } } } } while (0)

struct XcdBarrier {
    unsigned* bar; unsigned x; int w;
    volatile LAS unsigned* st;
};

__device__ __forceinline__ XcdBarrier xcd_barrier_post(unsigned* bar, volatile LAS unsigned* st, int wave) {
    XcdBarrier b; b.bar = bar; b.x = xb_xcc_id(); b.st = st; b.w = wave;
    if (wave == 0 && lane_id() == 0) (void)xb_add(&bar[XB_XCNT(b.x)], 1u);
    return b;
}
__device__ __forceinline__ void xcd_barrier_complete(unsigned* bar, unsigned x, unsigned& nloc, unsigned& nx) {
    const unsigned G = gridDim.x * gridDim.y * gridDim.z;
    unsigned sum, cnt, mine, sp = 0u;
    for (;;) {
        sum = 0u; cnt = 0u; mine = 0u;
#pragma unroll
        for (unsigned j = 0; j < 16; ++j) { const unsigned c = xb_ld(&bar[XB_XCNT(j)]); sum += c; cnt += (c > 0u) ? 1u : 0u; mine = (j == x) ? c : mine; }
        if (sum == G) break;
        __builtin_amdgcn_s_sleep(1);
        if ((++sp & 255u) == 0u) { if (xb_ld(&bar[XB_TMO])) break; if (sp > XB_SPIN_CAP) { atomicAdd(&bar[XB_TMO], 1u); break; } }
    }
    nloc = mine > 0u ? mine : 1u; nx = cnt > 0u ? cnt : 1u;
}

__device__ __forceinline__ void xcd_barrier(const XcdBarrier& b) {
    asm volatile("s_waitcnt vmcnt(0)" ::: "memory");
    __syncthreads();
    if (b.w == 0 && lane_id() == 0) {
        unsigned* bar = b.bar;
        __builtin_amdgcn_s_waitcnt(0);
        unsigned nloc = b.st[0], nx = b.st[1];
        if (nloc == 0u) { xcd_barrier_complete(bar, b.x, nloc, nx); b.st[0] = nloc; b.st[1] = nx; }
        const unsigned old = xb_add(&bar[XB_XSUB(b.x)], 1u);
        const unsigned gen = old / nloc;
        if (old + 1u == (gen + 1u) * nloc) {
            __builtin_amdgcn_fence(__ATOMIC_RELEASE, "agent");
            asm volatile("s_waitcnt vmcnt(0)" ::: "memory");
            const unsigned og = xb_add(&bar[XB_TOP], 1u);
            const unsigned tg = og / nx;
            if (og + 1u == (tg + 1u) * nx) xb_add(&bar[XB_TOPGEN], 1u);
            else XB_SPIN(xb_ld(&bar[XB_TOPGEN]) == tg, bar);
            __builtin_amdgcn_fence(__ATOMIC_ACQUIRE, "agent");
            xb_add(&bar[XB_XGEN(b.x)], 1u);
            asm volatile("s_waitcnt vmcnt(0)" ::: "memory");
        } else {
            XB_SPIN(xb_ld(&bar[XB_XGEN(b.x)]) == gen, bar);
            __builtin_amdgcn_fence(__ATOMIC_ACQUIRE, "agent");
            asm volatile("s_waitcnt vmcnt(0)" ::: "memory");
        }
    }
    __syncthreads();
}


__device__ __forceinline__ void chain_barrier(Ctx& C, unsigned* cnt, unsigned target, unsigned* tmo_bar) {
    asm volatile("s_waitcnt vmcnt(0)" ::: "memory");
    __syncthreads();
    if (C.tid == 0) { __builtin_amdgcn_fence(__ATOMIC_RELEASE, "agent"); asm volatile("s_waitcnt vmcnt(0)" ::: "memory"); (void)xb_add(cnt, 1u);
        XB_SPIN(xb_ld(cnt) < target, tmo_bar); __builtin_amdgcn_fence(__ATOMIC_ACQUIRE, "agent"); asm volatile("s_waitcnt vmcnt(0)" ::: "memory"); }
    __syncthreads();
}

struct Args { const float* in[24]; float* out; unsigned char* ws; int ph_lo, ph_hi; };
__global__ void __launch_bounds__(NWAVES * 64, 2) hybrid_fwd(Args args) {
    extern __shared__ __attribute__((aligned(16))) unsigned char lds_raw[];
    Ctx C;
    C.lds = (LAS unsigned char*)lds_raw;
    const int wave_s = __builtin_amdgcn_readfirstlane((int)(threadIdx.x >> 6));
    C.lane = lane_id(); C.wave = wave_s; C.tid = C.wave * 64 + C.lane;
    C.bid = blockIdx.x; C.nb = gridDim.x; C.gw = C.bid * NWAVES + C.wave; C.ngw = C.nb * NWAVES;
    typedef const unsigned long long __attribute__((address_space(4))) * KargP;
    const unsigned long long karg0 = (unsigned long long)__builtin_amdgcn_kernarg_segment_ptr();
#define LOAD_ARGS() do { unsigned long long _k = karg0; asm volatile("" : "+s"(_k)); KargP _p = (KargP)_k; \
        _Pragma("unroll") for (int _i = 0; _i < 24; ++_i) C.in[_i] = (const float*)_p[_i]; C.out = (float*)_p[24]; C.ws = (unsigned char*)_p[25]; } while (0)
    LOAD_ARGS();
    volatile LAS unsigned* MISC = (volatile LAS unsigned*)(C.lds + MISC_OFF);
    for (int u = C.tid; u < (LDS_BYTES - MISC_OFF) / 4; u += NWAVES * 64) ((LAS unsigned*)(C.lds + MISC_OFF))[u] = 0u;
    __syncthreads();
    const int lo = args.ph_lo, hi = args.ph_hi;
    XcdBarrier bar; bar.bar = (unsigned*)(C.ws + WS_CTL) + CW_BAR; bar.x = 0; bar.st = nullptr; bar.w = wave_s;
    if (hi - lo > 1) bar = xcd_barrier_post((unsigned*)(C.ws + WS_CTL) + CW_BAR, MISC + 8, wave_s);
#define IN(k) (lo <= (k) && (k) < hi)
#define PHASE_BEGIN() do { LOAD_ARGS(); C.lane = launder_v(lane_id()); C.wave = wave_s; C.tid = C.wave * 64 + C.lane; C.gw = C.bid * NWAVES + C.wave; } while (0)
#define SEAM(k) do { if (IN(k) && IN((k) + 1)) xcd_barrier(bar); } while (0)
    LAS unsigned char* ring = C.lds;

    if (IN(0)) { PHASE_BEGIN();
        phase0(C, 1);
        asm volatile("s_waitcnt vmcnt(0)" ::: "memory");
        __syncthreads();
        { unsigned* ctl = (unsigned*)(C.ws + WS_CTL);
          if (C.tid == 0) { __builtin_amdgcn_fence(__ATOMIC_RELEASE, "agent"); asm volatile("s_waitcnt vmcnt(0)" ::: "memory"); (void)xb_add(ctl + 192, 1u); } }
        phase0(C, 22);
        PHASE_BEGIN();
        { unsigned* ctl = (unsigned*)(C.ws + WS_CTL);
          if (C.tid == 0) { XB_SPIN(xb_ld(ctl + 192) < (unsigned)C.nb, bar.bar); __builtin_amdgcn_fence(__ATOMIC_ACQUIRE, "agent"); asm volatile("s_waitcnt vmcnt(0)" ::: "memory"); }
          __syncthreads();
          const float* MOD = WSP(float, WS_MOD);
#pragma unroll 1
          for (;;) { unsigned t = 0u; if (C.lane == 0) t = xb_add(ctl + 256, 1u);
              t = (unsigned)__builtin_amdgcn_readfirstlane((int)t); if (t >= (unsigned)((T + NBATCH) / 8)) break;
              if (8 * (int)t < T) {
#pragma unroll 1
                  for (int r = 8 * (int)t; r < 8 * (int)t + 8; r += 4)
                      rmsnorm_rows4<true, true, false>(C.in[0] + (size_t)r * 1024, 1024, C.in[9], MOD, MOD + 1024, WSP(bf16, WS_H) + (size_t)r * 1024, 1024, C.lane);
              } else {
#pragma unroll 1
                  for (int r = 8 * (int)t; r < 8 * (int)t + 8; ++r) { const float* md = MOD + (size_t)(r - T + 1) * 6144;
                      rmsnorm_row<true, true>(C.in[1] + (size_t)(r - T) * 1024, C.in[9], md, md + 1024, WSP(bf16, WS_H) + (size_t)r * 1024, C.lane); } } }
        }
    } SEAM(1);
    if (IN(2)) { PHASE_BEGIN();
        pg8::Gemm g{WSP(bf16, WS_H), WSP(bf16, WS_WIN), T, NIN, 1024}; pg8::StaticOrder S; S.init(T, NIN, C.nb, C.bid);
        EpiIn E{C.ws, C.out};
        pg8::gemm_phase<EpiIn, pg8::StaticOrder, false, PG8_SP2>(ring, g, S, E, C.wave);
        skinny_phase(C, g.A, g.Bt, NIN, 1024, E);
        { const int hb = C.nb > 128 ? 128 : 0;
          if (C.bid >= hb) { PHASE_BEGIN(); asm volatile("s_waitcnt vmcnt(0)" ::: "memory"); __syncthreads(); late_prologue(C, (C.bid - hb) * NWAVES + C.wave, (C.nb - hb) * NWAVES); } }
    } SEAM(2);
    if (IN(3)) { PHASE_BEGIN();
        if (C.bid * NWAVES < 128) {
            stage_wcmp(C);
            for (int p = C.gw; p < 128; p += C.ngw) {
                const float* base0 = C.out + O_CMPP + (size_t)p * 128 * 256;
                cmp_build_page(base0, p < 127 ? base0 + 128 * 256 : nullptr, (const LAS float*)C.lds, C.in[16], WSP(bf16, WS_CMPKP), WSP(bf16, WS_CMPVP), p, C.lane); }
            __syncthreads();
        }
        for (int task = C.bid; task < 128; task += C.nb) ret_sample_task(C, task);
        { int t0 = C.bid - (128 % C.nb); if (t0 < 0) t0 += C.nb;
          for (int task = t0; task < 64; task += C.nb) nsa_sample_block(C, task); }
        { unsigned* qhead = (unsigned*)(C.ws + WS_CTL) + 16;
#pragma unroll 1
          for (;;) { unsigned t = 0u; if (C.lane == 0) t = __hip_atomic_fetch_add(qhead, 1u, __ATOMIC_RELAXED, __HIP_MEMORY_SCOPE_AGENT);
              t = (unsigned)__builtin_amdgcn_readfirstlane((int)t); if (t >= 2048u) break; ret_u_task(C, (int)t); } }
    } SEAM(3);
    if (IN(4)) { PHASE_BEGIN();
        unsigned* ctl = (unsigned*)(C.ws + WS_CTL);
        const int NSB = C.nb >= 128 ? 64 : C.nb;
        if (C.bid < NSB) {
            ret_scan(C, NSB);
            asm volatile("s_waitcnt vmcnt(0)" ::: "memory");
            __syncthreads();
            if (C.tid == 0) { __builtin_amdgcn_fence(__ATOMIC_RELEASE, "agent"); asm volatile("s_waitcnt vmcnt(0)" ::: "memory"); (void)xb_add(ctl + 64, 1u); }
        }
        { const int NSC = C.nb < 16 ? C.nb : 16;
          if (C.bid >= C.nb - NSC) {
              const int sb = C.bid - (C.nb - NSC); unsigned gen = 0u;
              { EpiMixA E6{C.ws}; EpiMixed E7{C.ws};
#pragma unroll 1
                for (int su = sb; su < 16; su += NSC) { skinny_subunit(C, WSP(bf16, WS_ONSA), WSP(bf16, WS_WBN), 512, su >> 2, su & 3, E6);
                    skinny_subunit(C, WSP(bf16, WS_YRET), WSP(bf16, WS_WBR), 1024, su >> 2, su & 3, E7); } }
              gen += (unsigned)NSC; chain_barrier(C, ctl + 384, gen, bar.bar);
              { EpiResid E8{C.ws, C.in[0], C.in[1], 2048, true};
#pragma unroll 1
                for (int su = sb; su < 16; su += NSC) skinny_subunit(C, WSP(bf16, WS_MIXED), WSP(bf16, WS_WO), 1024, su >> 2, su & 3, E8); }
              gen += (unsigned)NSC; chain_barrier(C, ctl + 384, gen, bar.bar);
              { const float* MOD = WSP(float, WS_MOD);
#pragma unroll 1
                for (int r = T + sb * NWAVES + C.wave; r < T + NBATCH; r += NSC * NWAVES) { const float* md = MOD + (size_t)(r - T + 1) * 6144;
                    rmsnorm_row<true>(WSP(float, WS_X1) + (size_t)r * 1024, C.in[10], md + 3072, md + 4096, WSP(bf16, WS_H2) + (size_t)r * 1024, C.lane); } }
              gen += (unsigned)NSC; chain_barrier(C, ctl + 384, gen, bar.bar);
              { EpiUp E10{C.ws};
#pragma unroll 1
                for (int su = sb; su < 64; su += NSC) skinny_subunit(C, WSP(bf16, WS_H2), WSP(bf16, WS_WUP), 1024, su >> 2, su & 3, E10); }
              gen += (unsigned)NSC; chain_barrier(C, ctl + 384, gen, bar.bar);
              { EpiResid E11{C.ws, C.in[0], C.in[1], 5120, false};
#pragma unroll 1
                for (int su = sb; su < 16; su += NSC) skinny_subunit(C, WSP(bf16, WS_UP), WSP(bf16, WS_WDN), FF, su >> 2, su & 3, E11); }
              gen += (unsigned)NSC; chain_barrier(C, ctl + 384, gen, bar.bar);
#pragma unroll 1
              for (int r = T + sb * NWAVES + C.wave; r < T + NBATCH; r += NSC * NWAVES)
                  rmsnorm_row<false, true, true>(WSP(float, WS_X2) + (size_t)r * 1024, C.in[11], nullptr, nullptr, C.out + O_YS + (size_t)(r - T) * 1024, C.lane);
              __syncthreads();
          } }
#pragma unroll 1
        for (;;) {
            if (C.tid == 0) MISC[16] = xb_add(ctl + 320, 1u);
            __syncthreads();
            const unsigned qi = MISC[16];
            __syncthreads();
            if (qi >= 512u) break;
            const int qbn = 255 - (int)(qi >> 1);
            nsa_block_task(C, (qi & 1u) ? 511 - qbn : qbn, WSP(bf16, WS_ONSA));
        }
        PHASE_BEGIN();
        ctl = (unsigned*)(C.ws + WS_CTL);
        if (C.tid == 0) { XB_SPIN(xb_ld(ctl + 64) < (unsigned)(C.nb >= 128 ? 64 : C.nb), bar.bar); __builtin_amdgcn_fence(__ATOMIC_ACQUIRE, "agent"); asm volatile("s_waitcnt vmcnt(0)" ::: "memory"); }
        __syncthreads();
#pragma unroll 1
        for (;;) {
            if (C.tid == 0) MISC[16] = xb_add(ctl + 128, 1u);
            __syncthreads();
            const unsigned bt = MISC[16];
            __syncthreads();
            if (bt >= 512u) break;
            ret_out_block(C, (int)bt);
        }
    } SEAM(4);
    if (IN(6)) { PHASE_BEGIN();
        pg8::Gemm g{WSP(bf16, WS_ONSA), WSP(bf16, WS_WBN), T, 1024, 512}; pg8::StaticOrder S; S.init(T, 1024, C.nb, C.bid);
        EpiMixA E{C.ws};
        pg8::gemm_phase<EpiMixA, pg8::StaticOrder, PG8_ALIGN, PG8_SP2>(ring, g, S, E, C.wave);
    }
    if (IN(7)) { PHASE_BEGIN();
        asm volatile("s_waitcnt vmcnt(0)" ::: "memory");
        __syncthreads();
        pg8::Gemm g{WSP(bf16, WS_YRET), WSP(bf16, WS_WBR), T, 1024, 1024}; pg8::StaticOrder S; S.init(T, 1024, C.nb, C.bid);
        EpiMixed E{C.ws};
        pg8::gemm_phase<EpiMixed, pg8::StaticOrder, PG8_ALIGN, PG8_SP2>(ring, g, S, E, C.wave);
    } SEAM(7);
    if (IN(8)) { PHASE_BEGIN();
        pg8::Gemm g{WSP(bf16, WS_MIXED), WSP(bf16, WS_WO), T, 1024, 1024}; pg8::StaticOrder S; S.init(T, 1024, C.nb, C.bid);
        EpiResid E{C.ws, C.in[0], C.in[1], 2048, true};
        pg8::gemm_phase<EpiResid, pg8::StaticOrder, PG8_ALIGN, PG8_SP2>(ring, g, S, E, C.wave);
    } SEAM(8);
    if (IN(9)) { PHASE_BEGIN();
        const float* MOD = WSP(float, WS_MOD);
#pragma unroll 1
        for (int r = 4 * C.gw; r < T; r += 4 * C.ngw)
            rmsnorm_rows4<true, false, false>(WSP(float, WS_X1) + (size_t)r * 1024, 1024, C.in[10], MOD + 3072, MOD + 4096, WSP(bf16, WS_H2) + (size_t)r * 1024, 1024, C.lane);
    } SEAM(9);
    if (IN(10)) { PHASE_BEGIN();
        pg8::Gemm g{WSP(bf16, WS_H2), WSP(bf16, WS_WUP), T, FF, 1024}; pg8::StaticOrder S; S.init(T, FF, C.nb, C.bid);
        EpiUp E{C.ws};
        pg8::gemm_phase<EpiUp, pg8::StaticOrder, PG8_ALIGN, PG8_SP2>(ring, g, S, E, C.wave);
    } SEAM(10);
    if (IN(11)) { PHASE_BEGIN();
        pg8::Gemm g{WSP(bf16, WS_UP), WSP(bf16, WS_WDN), T, 1024, FF}; pg8::StaticOrder S; S.init(T, 1024, C.nb, C.bid);
        EpiResid E{C.ws, C.in[0], C.in[1], 5120, false};
        pg8::gemm_phase<EpiResid, pg8::StaticOrder, PG8_ALIGN, PG8_SP2>(ring, g, S, E, C.wave);
    } SEAM(11);
    if (IN(12)) { PHASE_BEGIN();
#pragma unroll 1
        for (int r = 4 * C.gw; r < T; r += 4 * C.ngw)
            rmsnorm_rows4<false, true, true>(WSP(float, WS_X2) + (size_t)r * 1024, 1024, C.in[11], nullptr, nullptr, C.out + O_Y + (size_t)r * 1024, 1024, C.lane);
    }
#undef IN
#undef SEAM
}

extern "C" void kernel_launch(void* const* d_in, const int* in_sizes, int n_in, void* d_out, int out_size, void* d_ws, size_t ws_size, hipStream_t stream) {
    static int grid = 0;
    if (grid == 0) {
        if (n_in != 24 || (size_t)out_size != O_END || ws_size < WS_END) { fprintf(stderr, "kernel_launch: unexpected shapes (n_in %d, out %d, ws %zu, need %zu)\n", n_in, out_size, ws_size, (size_t)WS_END); grid = -1; return; }
        int dev = 0, cus = 0, per_cu = 0;
        if (hipGetDevice(&dev) != hipSuccess || hipDeviceGetAttribute(&cus, hipDeviceAttributeMultiprocessorCount, dev) != hipSuccess) { grid = -1; return; }
        if (hipFuncSetAttribute((const void*)hybrid_fwd, hipFuncAttributeMaxDynamicSharedMemorySize, LDS_BYTES) != hipSuccess) { fprintf(stderr, "kernel_launch: hipFuncSetAttribute failed\n"); grid = -1; return; }
        if (hipOccupancyMaxActiveBlocksPerMultiprocessor(&per_cu, (const void*)hybrid_fwd, NWAVES * 64, LDS_BYTES) != hipSuccess || per_cu < 1) { fprintf(stderr, "kernel_launch: occupancy query says %d\n", per_cu); per_cu = 1; }
        (void)hipGetLastError();
        grid = cus;
    }
    if (grid < 0) return;
    if (hipMemsetAsync((char*)d_ws + WS_CTL, 0, CTL_BYTES, stream) != hipSuccess) return;
    Args a{};
    for (int i = 0; i < 24; ++i) a.in[i] = (const float*)d_in[i];
    a.out = (float*)d_out; a.ws = (unsigned char*)d_ws;
#if MK_ONE_LAUNCH
    a.ph_lo = 0; a.ph_hi = N_PHASES;
    hipLaunchKernelGGL(hybrid_fwd, dim3(grid), dim3(NWAVES * 64), LDS_BYTES, stream, a);
#else
    for (int p = 0; p < N_PHASES; ++p) { a.ph_lo = p; a.ph_hi = p + 1;
        hipLaunchKernelGGL(hybrid_fwd, dim3(grid), dim3(NWAVES * 64), LDS_BYTES, stream, a); }
#endif
}
```
